# Optimizing an MI355X kernel written in HIP

```python
import math
import jax, jax.numpy as jnp
from jax import lax
import numpy as np

D_MODEL = 1024
BATCH = 16
SEQ = 2048
DEPTH = 4

HEAD_DIM = 64
N_BRANCHES = 3
LRU_W = D_MODEL
LRU_BLOCKS = D_MODEL // HEAD_DIM
LRU_BLOCK_W = LRU_W // LRU_BLOCKS
CONV_WIDTH = 4
LRU_C = 8.0
SWA_HEADS = D_MODEL // HEAD_DIM
SWA_KV_HEADS = SWA_HEADS // 4
SWA_GROUP = SWA_HEADS // SWA_KV_HEADS
SWA_WINDOW = 128
DIL_HEADS = D_MODEL // HEAD_DIM
DIL_CONFIGS = ((128, 1), (512, 4), (2048, 16))
FF_HIDDEN = int(math.ceil(8 * D_MODEL / 3 / 256) * 256)
DEEPNORM_ALPHA = (2.0 * DEPTH) ** 0.25
DEEPNORM_BETA = (8.0 * DEPTH) ** -0.25
LN_EPS = 1e-5
NEG_INF = -1e30
IN_WIDTHS = (LRU_W, LRU_W,
             SWA_HEADS * HEAD_DIM, SWA_KV_HEADS * HEAD_DIM, SWA_KV_HEADS * HEAD_DIM,
             DIL_HEADS * HEAD_DIM, DIL_HEADS * HEAD_DIM, DIL_HEADS * HEAD_DIM,
             N_BRANCHES * D_MODEL)
IN_WIDTH = sum(IN_WIDTHS)
BRANCH_W = D_MODEL

kernel_name = "hybrid_rglru_swa_sink_dilated_deepnorm"


def layer_norm(x, g, b):
    xf = x.astype(jnp.float32)
    mu = jnp.mean(xf, axis=-1, keepdims=True)
    var = jnp.mean(jnp.square(xf - mu), axis=-1, keepdims=True)
    y = (xf - mu) * lax.rsqrt(var + LN_EPS)
    return (y * g.astype(jnp.float32) + b.astype(jnp.float32)).astype(x.dtype)


def banded_window_attention(q, k, v, window, sink=None):
    bsz, L, hk, g, dh = q.shape
    blk = window
    nb = -(-L // blk)
    pad = nb * blk - L
    if pad:
        q = jnp.pad(q, ((0, 0), (0, pad), (0, 0), (0, 0), (0, 0)))
        k = jnp.pad(k, ((0, 0), (0, pad), (0, 0), (0, 0)))
        v = jnp.pad(v, ((0, 0), (0, pad), (0, 0), (0, 0)))
    qb = q.reshape(bsz, nb, blk, hk, g, dh)
    kb = k.reshape(bsz, nb, blk, hk, dh)
    vb = v.reshape(bsz, nb, blk, hk, dh)

    def with_prev(t):
        prev = jnp.pad(t[:, :-1], ((0, 0), (1, 0), (0, 0), (0, 0), (0, 0)))
        return jnp.concatenate([prev, t], axis=2)

    kk = with_prev(kb)
    vv = with_prev(vb)
    s = jnp.einsum('bnqhgd,bnkhd->bhgnqk', qb, kk,
                   preferred_element_type=jnp.float32) * (dh ** -0.5)
    qi = jnp.arange(blk)[:, None]
    kj = jnp.arange(2 * blk)[None, :]
    rel = qi + blk - kj
    key_exists = (jnp.arange(nb)[:, None, None] > 0) | (kj[None] >= blk)
    mask = (rel >= 0)[None] & (rel <= window)[None] & key_exists
    s = jnp.where(mask, s, NEG_INF)
    m = jnp.max(s, axis=-1)
    if sink is not None:
        sink_b = sink.astype(jnp.float32).reshape(hk, g, 1, 1)
        m = jnp.maximum(m, sink_b)
    p = jnp.exp(s - m[..., None])
    denom = jnp.sum(p, axis=-1)
    if sink is not None:
        denom = denom + jnp.exp(sink_b - m)
    o = jnp.einsum('bhgnqk,bnkhd->bnqhgd', p.astype(vv.dtype), vv,
                   preferred_element_type=jnp.float32)
    den_t = jnp.transpose(denom, (0, 3, 4, 1, 2))
    lse_t = jnp.transpose(m + jnp.log(denom), (0, 3, 4, 1, 2))
    o = (o / den_t[..., None]).reshape(bsz, nb * blk, hk, g, dh)[:, :L]
    lse = lse_t.reshape(bsz, nb * blk, hk, g)[:, :L]
    return o.astype(q.dtype), lse


def dilated_attention(q, k, v):
    bsz, S, H, dh = q.shape
    outs, lses = [], []
    for window, dil in DIL_CONFIGS:
        Ls = S // dil

        def to_sub(t):
            return t.reshape(bsz, Ls, dil, H, dh).transpose(0, 2, 1, 3, 4).reshape(bsz * dil, Ls, H, dh)

        o, lse = banded_window_attention(to_sub(q)[:, :, :, None], to_sub(k), to_sub(v), window // dil)
        o = o[:, :, :, 0].reshape(bsz, dil, Ls, H, dh).transpose(0, 2, 1, 3, 4).reshape(bsz, S, H, dh)
        lse = lse[:, :, :, 0].reshape(bsz, dil, Ls, H).transpose(0, 2, 1, 3).reshape(bsz, S, H)
        outs.append(o)
        lses.append(lse)
    w = jax.nn.softmax(jnp.stack(lses, axis=0), axis=0)
    o = jnp.sum(w[..., None] * jnp.stack(outs, axis=0).astype(jnp.float32), axis=0)
    return o.astype(q.dtype)


def rglru_branch(xr, gate_in, conv_w, conv_b, w_rg, b_rg, w_ig, b_ig, lru_lambda):
    bsz, S, W = xr.shape
    xp = jnp.pad(xr, ((0, 0), (CONV_WIDTH - 1, 0), (0, 0)))
    xc = sum(xp[:, j:j + S] * conv_w[j] for j in range(CONV_WIDTH)) + conv_b
    xh = xc.reshape(bsz, S, LRU_BLOCKS, LRU_BLOCK_W)
    r = jax.nn.sigmoid(jnp.einsum('bshi,hij->bshj', xh, w_rg).reshape(bsz, S, W) + b_rg)
    i = jax.nn.sigmoid(jnp.einsum('bshi,hij->bshj', xh, w_ig).reshape(bsz, S, W) + b_ig)
    log_a = -LRU_C * r.astype(jnp.float32) * jax.nn.softplus(-lru_lambda.astype(jnp.float32))
    a = jnp.exp(log_a)
    mult = jnp.sqrt(-jnp.expm1(2.0 * log_a))
    b = mult * (i * xc).astype(jnp.float32)

    def combine(e1, e2):
        a1, b1 = e1
        a2, b2 = e2
        return a1 * a2, a2 * b1 + b2

    _, h = lax.associative_scan(combine, (a, b), axis=1)
    return (h.astype(xr.dtype) * jax.nn.gelu(gate_in))


def hybrid_mixer(x, w_in, conv_w, conv_b, w_rg, b_rg, w_ig, b_ig, lru_lambda, sinks, w_branch, w_out):
    bsz, S, D = x.shape
    proj = x @ w_in
    split_at = list(np.cumsum(IN_WIDTHS)[:-1])
    lru_x, lru_gate, qb, kb, vb, qc, kc, vc, gates = jnp.split(proj, split_at, axis=-1)
    y_a = rglru_branch(lru_x, lru_gate, conv_w, conv_b, w_rg, b_rg, w_ig, b_ig, lru_lambda)
    o_b, _ = banded_window_attention(qb.reshape(bsz, S, SWA_KV_HEADS, SWA_GROUP, HEAD_DIM),
                                     kb.reshape(bsz, S, SWA_KV_HEADS, HEAD_DIM),
                                     vb.reshape(bsz, S, SWA_KV_HEADS, HEAD_DIM),
                                     SWA_WINDOW, sinks)
    y_b = o_b.reshape(bsz, S, SWA_HEADS * HEAD_DIM)
    y_c = dilated_attention(qc.reshape(bsz, S, DIL_HEADS, HEAD_DIM),
                            kc.reshape(bsz, S, DIL_HEADS, HEAD_DIM),
                            vc.reshape(bsz, S, DIL_HEADS, HEAD_DIM)).reshape(bsz, S, DIL_HEADS * HEAD_DIM)
    ys = jnp.stack([y_a, y_b, y_c], axis=2)
    branch = jnp.einsum('bsnc,ncd->bsnd', ys, w_branch)
    merged = jnp.sum(jax.nn.sigmoid(gates.reshape(bsz, S, N_BRANCHES, D)) * branch, axis=2)
    return merged @ w_out


def swiglu(x, w_ffn_in, w_ffn_out):
    h1, h3 = jnp.split(x @ w_ffn_in, 2, axis=-1)
    return (jax.nn.silu(h1) * h3) @ w_ffn_out


def setup_inputs(seed: int = 0) -> dict:
    key = jax.random.key(seed)
    ks = jax.random.split(key, 20)
    f32 = jnp.float32

    def nrm(k, shape, scale):
        return jax.random.normal(k, shape, f32) * scale

    u = jax.random.uniform(ks[7], (DEPTH, LRU_W), f32, 0.9, 0.999)
    return {
        "x": jax.random.normal(ks[0], (BATCH, SEQ, D_MODEL), f32),
        "w_in": nrm(ks[1], (DEPTH, D_MODEL, IN_WIDTH), D_MODEL ** -0.5),
        "conv_w": nrm(ks[2], (DEPTH, CONV_WIDTH, LRU_W), CONV_WIDTH ** -0.5),
        "conv_b": nrm(ks[3], (DEPTH, LRU_W), 0.02),
        "w_rg": nrm(ks[4], (DEPTH, LRU_BLOCKS, LRU_BLOCK_W, LRU_BLOCK_W), LRU_BLOCK_W ** -0.5),
        "b_rg": nrm(ks[5], (DEPTH, LRU_W), 0.02),
        "w_ig": nrm(ks[6], (DEPTH, LRU_BLOCKS, LRU_BLOCK_W, LRU_BLOCK_W), LRU_BLOCK_W ** -0.5),
        "b_ig": nrm(ks[8], (DEPTH, LRU_W), 0.02),
        "lru_lambda": jnp.log(u / (1.0 - u)),
        "sinks": nrm(ks[9], (DEPTH, SWA_HEADS), 0.5),
        "w_branch": nrm(ks[10], (DEPTH, N_BRANCHES, BRANCH_W, D_MODEL), DEEPNORM_BETA * BRANCH_W ** -0.5),
        "w_out": nrm(ks[11], (DEPTH, D_MODEL, D_MODEL), DEEPNORM_BETA * D_MODEL ** -0.5),
        "ln1_g": 1.0 + nrm(ks[12], (DEPTH, D_MODEL), 0.02),
        "ln1_b": nrm(ks[13], (DEPTH, D_MODEL), 0.02),
        "w_ffn_in": nrm(ks[14], (DEPTH, D_MODEL, 2 * FF_HIDDEN), DEEPNORM_BETA * D_MODEL ** -0.5),
        "w_ffn_out": nrm(ks[15], (DEPTH, FF_HIDDEN, D_MODEL), DEEPNORM_BETA * FF_HIDDEN ** -0.5),
        "ln2_g": 1.0 + nrm(ks[16], (DEPTH, D_MODEL), 0.02),
        "ln2_b": nrm(ks[17], (DEPTH, D_MODEL), 0.02),
    }


def reference(x, w_in, conv_w, conv_b, w_rg, b_rg, w_ig, b_ig, lru_lambda, sinks, w_branch, w_out,
              ln1_g, ln1_b, w_ffn_in, w_ffn_out, ln2_g, ln2_b):
    for l in range(DEPTH):
        mix = hybrid_mixer(x, w_in[l], conv_w[l], conv_b[l], w_rg[l], b_rg[l], w_ig[l], b_ig[l],
                           lru_lambda[l], sinks[l], w_branch[l], w_out[l])
        x = layer_norm(DEEPNORM_ALPHA * x + mix, ln1_g[l], ln1_b[l])
        ffn = swiglu(x, w_ffn_in[l], w_ffn_out[l])
        x = layer_norm(DEEPNORM_ALPHA * x + ffn, ln2_g[l], ln2_b[l])
    return x
```

```cpp
#include <hip/hip_runtime.h>
#include <hip/hip_cooperative_groups.h>
#include <cstdio>
namespace cg = cooperative_groups;

#ifndef MK_MULTI
#define MK_MULTI 0
#endif

#ifndef PH_MASK
#define PH_MASK 255
#endif
#define LAS __attribute__((address_space(3)))
typedef unsigned short bf16_t;
typedef short bf16x8 __attribute__((ext_vector_type(8)));
typedef short s16x4 __attribute__((ext_vector_type(4)));
typedef float f32x4 __attribute__((ext_vector_type(4)));
typedef float f32x16 __attribute__((ext_vector_type(16)));
typedef unsigned u32x4 __attribute__((ext_vector_type(4)));
typedef unsigned u32x2 __attribute__((ext_vector_type(2)));

constexpr int DM = 1024, SEQ = 2048, BATCH = 16, DEPTH = 4, INW = 9728, FFH = 2816, FF2 = 5632;
constexpr int NCH = 2, MC = 16384, SEQ_PER_CH = 8, MTOT = BATCH * SEQ;
constexpr int C_LX = 0, C_LG = 1024, C_QB = 2048, C_KB = 3072, C_VB = 3328, C_QC = 3584, C_KC = 4608, C_VC = 5632, C_GATE = 6656;
constexpr float LN_EPS = 1e-5f;
constexpr float ALPHA = 1.681792830507429f;
constexpr float LOG2E = 1.4426950408889634f;
constexpr size_t MiB = 1u << 20;
constexpr size_t WS_WIN = 0, WS_WBR = 19 * MiB, WS_WOUT = 25 * MiB, WS_WF1 = 27 * MiB, WS_WF2 = 38 * MiB, WS_XB = 44 * MiB, WS_PROJ = 108 * MiB,
                 WS_Y = 412 * MiB, WS_MRG = 508 * MiB, WS_END = 540 * MiB, WS_H = WS_PROJ;
constexpr int LDS_BYTES = 147456;
constexpr int NPH = 1 + DEPTH * 17;

__device__ __forceinline__ unsigned f2bf(float f) { unsigned u = __builtin_bit_cast(unsigned, f); return (u + 0x7fffu + ((u >> 16) & 1u)) >> 16; }
__device__ __forceinline__ unsigned pk2(float lo, float hi) { unsigned r; asm volatile("v_cvt_pk_bf16_f32 %0, %1, %2" : "=v"(r) : "v"(lo), "v"(hi)); return r; }
__device__ __forceinline__ float bf_lo(unsigned w) { return __builtin_bit_cast(float, w << 16); }
__device__ __forceinline__ float bf_hi(unsigned w) { return __builtin_bit_cast(float, w & 0xffff0000u); }
__device__ __forceinline__ float bf2f(bf16_t b) { return __builtin_bit_cast(float, ((unsigned)b) << 16); }
__device__ __forceinline__ float ex2(float x) { return __builtin_amdgcn_exp2f(x); }
__device__ __forceinline__ float rcpf_(float x) { return __builtin_amdgcn_rcpf(x); }
__device__ __forceinline__ float sigm(float x) { return rcpf_(1.0f + ex2(-x * LOG2E)); }
__device__ __forceinline__ float wave_sum(float v) {
#pragma unroll
    for (int o = 1; o < 64; o <<= 1) v += __shfl_xor(v, o);
    return v;
}
#define LDS_WAIT() asm volatile("s_waitcnt lgkmcnt(0)" ::: "memory")

namespace pg8 {
constexpr int BM = 256, BK = 64, HALF = 128, HTB = HALF * BK * 2, STAGE_BYTES = 8 * HTB, NXCD = 8, WGM = 8;
__host__ __device__ __forceinline__ int lds_byte(int r, int c) { const int st = (r >> 4) * 2 + (c >> 5), rr = r & 15, cc = c & 31, ob = rr * 64 + cc * 2; return st * 1024 + (ob ^ (((ob >> 9) & 1) << 5)); }
__host__ __device__ __forceinline__ void stage_rc(int b, int& R, int& C) { const int st = b / 1024, sb = b % 1024, swz = sb ^ (((sb >> 9) & 1) << 5); R = (st >> 1) * 16 + swz / 64; C = (st & 1) * 32 + (swz % 64) / 2; }
__host__ __device__ __forceinline__ int perm32(int rho) { const int n = rho >> 4, i = rho & 15; return 8 * (i >> 2) + 4 * n + (i & 3); }
struct Unit { int pm, pn; };
struct StaticOrder {
    int nM, nN, nwg, G, c;
    __device__ void init(int M, int N, int G_, int c_) { nM = M / BM; nN = N / BM; nwg = nM * nN; G = G_; c = c_; }
    __device__ bool next(int i, Unit& u) const {
        const long L = (long)i * G + c; if (L >= nwg) return false;
        int wgid = (int)L; { const int q = nwg / NXCD, r = nwg % NXCD, xcd = wgid % NXCD, off = wgid / NXCD; wgid = (xcd < r ? xcd * (q + 1) : r * (q + 1) + (xcd - r) * q) + off; }
        const int nig = WGM * nN, gid = wgid / nig, fm = gid * WGM, gsz = (nM - fm) < WGM ? (nM - fm) : WGM;
        u.pm = fm + ((wgid % nig) % gsz); u.pn = (wgid % nig) / gsz; return true;
    }
};
struct BranchOrder {
    StaticOrder so;
    __device__ void init(int G_, int c_) { so.init(MC, DM, G_, c_); }
    __device__ bool next(int i, Unit& u) const { const int t = i / 3, n = i - 3 * t; Unit b; if (!so.next(t, b)) return false; u.pm = n * (MC / BM) + b.pm; u.pn = n * (DM / BM) + b.pn; return true; }
};

typedef f32x4 Acc[2][2][4][2];

struct EpiProj {
    static constexpr bool PERM = true;
    bf16_t* O; int ldc;
    __device__ __forceinline__ bool operator()(Acc& acc, const Unit& u, int wr, int wc, int fr, int fq) const {
        const int row0 = u.pm * BM + wr * 64 + fr, col0 = u.pn * BM + wc * 32 + 8 * fq;
#pragma unroll
        for (int ai = 0; ai < 2; ++ai)
#pragma unroll
            for (int m = 0; m < 4; ++m) { bf16_t* rowp = O + (size_t)(row0 + ai * HALF + m * 16) * ldc + col0;
#pragma unroll
                for (int bj = 0; bj < 2; ++bj) { const f32x4 v0 = acc[ai][bj][m][0], v1 = acc[ai][bj][m][1];
                    u32x4 w; w.x = pk2(v0[0], v0[1]); w.y = pk2(v0[2], v0[3]); w.z = pk2(v1[0], v1[1]); w.w = pk2(v1[2], v1[3]);
                    *(u32x4*)(rowp + bj * HALF) = w; } }
        return false;
    }
};
struct EpiBranch {
    static constexpr bool PERM = true;
    const bf16_t* P; bf16_t* O;
    __device__ __forceinline__ bool operator()(Acc& acc, const Unit& u, int wr, int wc, int fr, int fq) const {
        const int n = u.pn >> 2, pn = u.pn & 3, pm = u.pm & 63;
        const int row0 = pm * BM + wr * 64 + fr, col0 = pn * BM + wc * 32 + 8 * fq;
#pragma unroll
        for (int ai = 0; ai < 2; ++ai)
#pragma unroll
            for (int m = 0; m < 4; ++m) { const int row = row0 + ai * HALF + m * 16;
#pragma unroll
                for (int bj = 0; bj < 2; ++bj) {
                    const bf16_t* gp = P + (size_t)row * INW + C_GATE + n * DM + col0 + bj * HALF;
                    const u32x4 ga = *(const u32x4*)gp; u32x4 gb = ga; if (n < 2) gb = *(const u32x4*)(gp + DM);
                    float fa[8], fb[8];
                    fa[0] = bf_lo(ga.x); fa[1] = bf_hi(ga.x); fa[2] = bf_lo(ga.y); fa[3] = bf_hi(ga.y); fa[4] = bf_lo(ga.z); fa[5] = bf_hi(ga.z); fa[6] = bf_lo(ga.w); fa[7] = bf_hi(ga.w);
                    fb[0] = bf_lo(gb.x); fb[1] = bf_hi(gb.x); fb[2] = bf_lo(gb.y); fb[3] = bf_hi(gb.y); fb[4] = bf_lo(gb.z); fb[5] = bf_hi(gb.z); fb[6] = bf_lo(gb.w); fb[7] = bf_hi(gb.w);
                    float v[8];
#pragma unroll
                    for (int j = 0; j < 8; ++j) { const float da = 1.0f + ex2(-fa[j] * LOG2E); const float nb = (n < 2) ? (1.0f + ex2(-fb[j] * LOG2E)) : 1.0f;
                        const float f = nb * rcpf_(da); v[j] = acc[ai][bj][m][j >> 2][j & 3] * f; }
                    acc[ai][bj][m][0] = (f32x4){v[0], v[1], v[2], v[3]}; acc[ai][bj][m][1] = (f32x4){v[4], v[5], v[6], v[7]};
                    if (n == 2) { u32x4 w; w.x = pk2(v[0], v[1]); w.y = pk2(v[2], v[3]); w.z = pk2(v[4], v[5]); w.w = pk2(v[6], v[7]);
                        *(u32x4*)(O + (size_t)row * DM + col0 + bj * HALF) = w; }
                } }
        return n < 2;
    }
};
struct EpiResid {
    static constexpr bool PERM = false;
    const float* src; float* dst;
    __device__ __forceinline__ bool operator()(Acc& acc, const Unit& u, int wr, int wc, int fr, int fq) const {
        const int row0 = u.pm * BM + wr * 64 + fr, col0 = u.pn * BM + wc * 32 + 4 * fq;
#pragma unroll
        for (int ai = 0; ai < 2; ++ai)
#pragma unroll
            for (int m = 0; m < 4; ++m) { const size_t off = (size_t)(row0 + ai * HALF + m * 16) * DM + col0;
#pragma unroll
                for (int bj = 0; bj < 2; ++bj)
#pragma unroll
                    for (int n = 0; n < 2; ++n) { const f32x4 bs = *(const f32x4*)(src + off + bj * HALF + n * 16); *(f32x4*)(dst + off + bj * HALF + n * 16) = bs * ALPHA + acc[ai][bj][m][n]; } }
        return false;
    }
};
struct EpiSwiGLU {
    static constexpr bool PERM = true;
    bf16_t* H;
    __device__ __forceinline__ bool operator()(Acc& acc, const Unit& u, int wr, int wc, int fr, int fq) const {
        const int row0 = u.pm * BM + wr * 64 + fr, col0 = u.pn * 128 + wc * 16 + 4 * fq;
#pragma unroll
        for (int ai = 0; ai < 2; ++ai)
#pragma unroll
            for (int m = 0; m < 4; ++m) { bf16_t* rowp = H + (size_t)(row0 + ai * HALF + m * 16) * FFH + col0;
#pragma unroll
                for (int bj = 0; bj < 2; ++bj) { const f32x4 a = acc[ai][bj][m][0], b = acc[ai][bj][m][1]; float v[4];
#pragma unroll
                    for (int j = 0; j < 4; ++j) v[j] = a[j] * sigm(a[j]) * b[j];
                    u32x2 w; w.x = pk2(v[0], v[1]); w.y = pk2(v[2], v[3]); *(u32x2*)(rowp + bj * 64) = w; } }
        return false;
    }
};

template <class Epi, class Sched>
__device__ __forceinline__ void gemm_phase(LAS unsigned char* lds, const bf16_t* Ab, int lda, const bf16_t* Btb, int K, const Sched& S, const Epi& E, const int tid) {
    const int wid = __builtin_amdgcn_readfirstlane(tid >> 6), lane = tid & 63, wr = wid >> 2, wc = wid & 3, fr = lane & 15, fq = lane >> 4;
    const int nt = K / BK;
    unsigned voffA[2], voffB[2];
#pragma unroll
    for (int i = 0; i < 2; ++i) { int R, C; stage_rc(tid * 16 + i * 8192, R, C); const int Rb = Epi::PERM ? ((R & ~31) + perm32(R & 31)) : R;
        voffA[i] = (unsigned)(R * lda + C) * 2u; voffB[i] = (unsigned)(Rb * K + C) * 2u; }
    const size_t kstep = (size_t)(BK * 2);
    const size_t hstepA = (size_t)HALF * lda * 2, tstepA = 2 * hstepA, hstepB = (size_t)HALF * K * 2, tstepB = 2 * hstepB;
    const unsigned ldsw = (unsigned)wid * 1024u;
    const int aoff = lds_byte(wr * 64 + fr, fq * 8), boff = lds_byte(wc * 32 + fr, fq * 8);
#define PG8_SA(b, h) (((b) * 2 + (h)) * HTB)
#define PG8_SB(b, h) ((4 + (b) * 2 + (h)) * HTB)
#define PG8_STAGE(bufoff, gbase, voff) do { _Pragma("unroll") for (int _i = 0; _i < 2; ++_i) \
        __builtin_amdgcn_global_load_lds((const unsigned*)((const char*)(gbase) + (voff)[_i]), (LAS unsigned*)(lds + (bufoff) + ldsw + _i * 8192), 16, 0, 0); } while (0)
#define PG8_LDA(dst, b, h) do { _Pragma("unroll") for (int m = 0; m < 4; ++m) _Pragma("unroll") for (int k = 0; k < 2; ++k) dst[m][k] = *(const LAS bf16x8*)(lds + PG8_SA(b, h) + aoff + m * 2048 + k * 1024); } while (0)
#define PG8_LDB(dst, b, h) do { _Pragma("unroll") for (int n = 0; n < 2; ++n) _Pragma("unroll") for (int k = 0; k < 2; ++k) dst[n][k] = *(const LAS bf16x8*)(lds + PG8_SB(b, h) + boff + n * 2048 + k * 1024); } while (0)
#define PG8_MMA(ai, bj, At, Bt) do { __builtin_amdgcn_s_setprio(1); _Pragma("unroll") for (int m = 0; m < 4; ++m) _Pragma("unroll") for (int n = 0; n < 2; ++n) _Pragma("unroll") for (int k = 0; k < 2; ++k) \
        acc[ai][bj][m][n] = __builtin_amdgcn_mfma_f32_16x16x32_bf16(Bt[n][k], At[m][k], acc[ai][bj][m][n], 0, 0, 0); __builtin_amdgcn_s_setprio(0); } while (0)
#define PG8_WAIT_V(n) asm volatile("s_waitcnt vmcnt(" #n ")" ::: "memory")
#define PG8_WAIT_L(n) asm volatile("s_waitcnt lgkmcnt(" #n ")" ::: "memory")
#define PG8_BAR __builtin_amdgcn_s_barrier()
#define PG8_SCHED __builtin_amdgcn_sched_barrier(0)
    Unit cur, nxt; int ui = 0;
    if (!S.next(0, cur)) return;
    Acc acc;
#pragma unroll
    for (int a = 0; a < 2; ++a)
#pragma unroll
        for (int b = 0; b < 2; ++b)
#pragma unroll
            for (int m = 0; m < 4; ++m)
#pragma unroll
                for (int n = 0; n < 2; ++n) acc[a][b][m][n] = (f32x4){0.f, 0.f, 0.f, 0.f};
    bf16x8 At[4][2], B0[2][2], B1[2][2];
    const char* cA = (const char*)Ab + (size_t)cur.pm * tstepA; const char* cB = (const char*)Btb + (size_t)cur.pn * tstepB;
    PG8_STAGE(PG8_SB(0, 0), cB, voffB); PG8_STAGE(PG8_SB(0, 1), cB + hstepB, voffB); PG8_STAGE(PG8_SA(0, 0), cA, voffA); PG8_STAGE(PG8_SA(0, 1), cA + hstepA, voffA);
    if (wr == 1) PG8_BAR;
    PG8_WAIT_V(2); PG8_BAR;
    PG8_STAGE(PG8_SB(1, 0), cB + kstep, voffB); PG8_STAGE(PG8_SA(1, 0), cA + kstep, voffA); PG8_STAGE(PG8_SB(1, 1), cB + hstepB + kstep, voffB);
    PG8_WAIT_V(6); PG8_BAR;
    for (;;) {
        const bool has_next = S.next(ui + 1, nxt);
        const char* nA = has_next ? (const char*)Ab + (size_t)nxt.pm * tstepA : cA; const char* nB = has_next ? (const char*)Btb + (size_t)nxt.pn * tstepB : cB;
        for (int t = 0; t < nt; t += 2) {
            const bool last = (t == nt - 2);
            const char* a1 = cA + (size_t)(t + 1) * kstep;
            const char* a2 = last ? nA : cA + (size_t)(t + 2) * kstep; const char* b2 = last ? nB : cB + (size_t)(t + 2) * kstep;
            const char* a3 = a2 + kstep; const char* b3 = b2 + kstep;
            PG8_LDB(B0, 0, 0); PG8_LDB(B1, 0, 1); PG8_SCHED; PG8_LDA(At, 0, 0); PG8_STAGE(PG8_SA(1, 1), a1 + hstepA, voffA);
            PG8_WAIT_V(8); PG8_WAIT_L(0); PG8_BAR; PG8_MMA(0, 0, At, B0); PG8_MMA(0, 1, At, B1); PG8_BAR; PG8_SCHED;
            PG8_LDA(At, 0, 1); PG8_STAGE(PG8_SB(0, 0), b2, voffB); PG8_STAGE(PG8_SB(0, 1), b2 + hstepB, voffB); PG8_STAGE(PG8_SA(0, 0), a2, voffA);
            PG8_WAIT_V(8); PG8_WAIT_L(0); PG8_BAR; PG8_MMA(1, 0, At, B0); PG8_MMA(1, 1, At, B1); PG8_BAR; PG8_SCHED;
            PG8_LDB(B0, 1, 0); PG8_LDB(B1, 1, 1); PG8_SCHED; PG8_LDA(At, 1, 0); PG8_STAGE(PG8_SA(0, 1), a2 + hstepA, voffA);
            PG8_WAIT_V(8); PG8_WAIT_L(0); PG8_BAR; PG8_MMA(0, 0, At, B0); PG8_MMA(0, 1, At, B1); PG8_BAR; PG8_SCHED;
            PG8_LDA(At, 1, 1); PG8_STAGE(PG8_SB(1, 0), b3, voffB); PG8_STAGE(PG8_SB(1, 1), b3 + hstepB, voffB); PG8_STAGE(PG8_SA(1, 0), a3, voffA);
            PG8_WAIT_V(8); PG8_WAIT_L(0); PG8_BAR; PG8_MMA(1, 0, At, B0); PG8_MMA(1, 1, At, B1); PG8_BAR; PG8_SCHED;
        }
        if (wr == 0) PG8_BAR;
        const bool keep = E(acc, cur, wr, wc, fr, fq);
        if (!has_next) break;
        if (!keep) {
#pragma unroll
            for (int a = 0; a < 2; ++a)
#pragma unroll
                for (int b = 0; b < 2; ++b)
#pragma unroll
                    for (int m = 0; m < 4; ++m)
#pragma unroll
                        for (int n = 0; n < 2; ++n) acc[a][b][m][n] = (f32x4){0.f, 0.f, 0.f, 0.f};
        }
        cur = nxt; cA = nA; cB = nB; ++ui;
        if (wr == 1) PG8_BAR;
    }
    PG8_WAIT_V(0);
    PG8_BAR;
#undef PG8_SA
#undef PG8_SB
#undef PG8_STAGE
#undef PG8_LDA
#undef PG8_LDB
#undef PG8_MMA
#undef PG8_WAIT_V
#undef PG8_WAIT_L
#undef PG8_BAR
#undef PG8_SCHED
}
}

struct Args { const float* in[18]; float* out; unsigned char* ws; int ph_lo, ph_hi; };
enum { I_X = 0, I_WIN, I_CONVW, I_CONVB, I_WRG, I_BRG, I_WIG, I_BIG, I_LAM, I_SINK, I_WBR, I_WOUT, I_LN1G, I_LN1B, I_WF1, I_WF2, I_LN2G, I_LN2B };

template <int MODE>
__device__ __forceinline__ void transpose_item(const float* W, int K, int N, bf16_t* WT, int row_off, LAS float* scr, int item, int lane) {
    const int nblk = N / 32, kb = item / nblk, nb = item % nblk, k0 = 64 * kb, n0 = 32 * nb;
#pragma unroll 8
    for (int i = 0; i < 32; ++i) { const int kk = 2 * i + (lane >> 5); scr[kk * 33 + (lane & 31)] = W[(size_t)(k0 + kk) * N + n0 + (lane & 31)]; }
    LDS_WAIT();
    const int c = lane & 7;
#pragma unroll
    for (int j = 0; j < 4; ++j) { const int n = (lane >> 3) + 8 * j; const LAS float* s = scr + (8 * c) * 33 + n;
        u32x4 o; o.x = pk2(s[0 * 33], s[1 * 33]); o.y = pk2(s[2 * 33], s[3 * 33]); o.z = pk2(s[4 * 33], s[5 * 33]); o.w = pk2(s[6 * 33], s[7 * 33]);
        int row = n0 + n;
        if (MODE == 1) { const int sgl = row >= FFH ? 1 : 0; const int jj = row - sgl * FFH; row = 8 * (jj >> 2) + 4 * sgl + (jj & 3); }
        *(u32x4*)(WT + (size_t)(row_off + row) * K + k0 + 8 * c) = o; }
    LDS_WAIT();
}
__device__ __forceinline__ void phase_weights(const Args& a, int l, LAS unsigned char* lds, int gw, int NGW, int wave, int lane) {
    LAS float* scr = (LAS float*)(lds + wave * 16384);
    unsigned char* ws = a.ws;
    constexpr int I_IN = 16 * (INW / 32), I_BR1 = 16 * 32, I_OUT = 16 * 32, I_F1 = 16 * (FF2 / 32), I_F2 = (FFH / 64) * 32;
    constexpr int NIT = I_IN + 3 * I_BR1 + I_OUT + I_F1 + I_F2;
    for (int it = gw; it < NIT; it += NGW) {
        int r = it;
        if (r < I_IN) { transpose_item<0>(a.in[I_WIN] + (size_t)l * DM * INW, DM, INW, (bf16_t*)(ws + WS_WIN), 0, scr, r, lane); continue; } r -= I_IN;
        if (r < 3 * I_BR1) { const int n = r / I_BR1; transpose_item<0>(a.in[I_WBR] + ((size_t)l * 3 + n) * DM * DM, DM, DM, (bf16_t*)(ws + WS_WBR), n * DM, scr, r - n * I_BR1, lane); continue; } r -= 3 * I_BR1;
        if (r < I_OUT) { transpose_item<0>(a.in[I_WOUT] + (size_t)l * DM * DM, DM, DM, (bf16_t*)(ws + WS_WOUT), 0, scr, r, lane); continue; } r -= I_OUT;
        if (r < I_F1) { transpose_item<1>(a.in[I_WF1] + (size_t)l * DM * FF2, DM, FF2, (bf16_t*)(ws + WS_WF1), 0, scr, r, lane); continue; } r -= I_F1;
        transpose_item<0>(a.in[I_WF2] + (size_t)l * FFH * DM, FFH, DM, (bf16_t*)(ws + WS_WF2), 0, scr, r, lane);
    }
}

__device__ __forceinline__ void phase_ln(float* zx, bf16_t* xb, const float* g, const float* b, int nrows, int gw, int NGW, int lane) {
    f32x4 gv[4], bv[4];
#pragma unroll
    for (int j = 0; j < 4; ++j) { gv[j] = *((const f32x4*)g + lane + 64 * j); bv[j] = *((const f32x4*)b + lane + 64 * j); }
    for (int m = gw; m < nrows; m += NGW) {
        f32x4* xr = (f32x4*)(zx + (size_t)m * DM) + lane;
        f32x4 v[4]; float s = 0.f;
#pragma unroll
        for (int j = 0; j < 4; ++j) { v[j] = xr[64 * j]; s += (v[j].x + v[j].y) + (v[j].z + v[j].w); }
        const float mean = wave_sum(s) * (1.f / DM); float s2 = 0.f;
#pragma unroll
        for (int j = 0; j < 4; ++j) { v[j] = v[j] - mean; s2 += (v[j].x * v[j].x + v[j].y * v[j].y) + (v[j].z * v[j].z + v[j].w * v[j].w); }
        const float rstd = 1.f / sqrtf(wave_sum(s2) * (1.f / DM) + LN_EPS);
        u32x2* o8 = (u32x2*)(xb + (size_t)m * DM) + lane;
#pragma unroll
        for (int j = 0; j < 4; ++j) { const f32x4 y = v[j] * rstd * gv[j] + bv[j]; xr[64 * j] = y; u32x2 w; w.x = pk2(y.x, y.y); w.y = pk2(y.z, y.w); o8[64 * j] = w; }
    }
}
__device__ __forceinline__ void phase_init(const float* x, bf16_t* xb, int gw, int NGW, int lane) {
    for (int m = gw; m < MTOT; m += NGW) {
        const f32x4* xr = (const f32x4*)(x + (size_t)m * DM) + lane; u32x2* o8 = (u32x2*)(xb + (size_t)m * DM) + lane;
#pragma unroll
        for (int j = 0; j < 4; ++j) { const f32x4 y = xr[64 * j]; u32x2 w; w.x = pk2(y.x, y.y); w.y = pk2(y.z, y.w); o8[64 * j] = w; }
    }
}

constexpr int LRU_A_OFF = 0, LRU_A_PITCH = 144, LRU_XF_OFF = 18432, LRU_XF_PITCH = 33, LRU_AGG_OFF = 18432 + 128 * 33 * 4  , LRU_CARRY_OFF = LRU_AGG_OFF + 8 * 32 * 8;
__device__ __forceinline__ void lru_item(const Args& a, int l, int item, LAS unsigned char* lds, const bf16_t* P, bf16_t* Ya, int tid, int wave, int lane) {
    const int bl = item >> 5, hb = (item >> 1) & 15, half = item & 1;
    const int row0 = bl * SEQ, chb = 64 * hb, cho = chb + 32 * half;
    LAS unsigned char* Abuf = lds + LRU_A_OFF; LAS float* xcf = (LAS float*)(lds + LRU_XF_OFF); LAS float* wagg = (LAS float*)(lds + LRU_AGG_OFF); LAS float* carry = (LAS float*)(lds + LRU_CARRY_OFF);
    const int fr = lane & 15, q = lane >> 4;
    bf16x8 bw[4][2];
#pragma unroll
    for (int nt = 0; nt < 4; ++nt) { const float* wsrc = (nt < 2 ? a.in[I_WRG] : a.in[I_WIG]) + ((size_t)(l * 16 + hb) * 64) * 64 + 32 * half + 16 * (nt & 1) + fr;
#pragma unroll
        for (int ks = 0; ks < 2; ++ks) { unsigned w[4];
#pragma unroll
            for (int j = 0; j < 4; ++j) { const int k = 32 * ks + 8 * q + 2 * j; w[j] = pk2(wsrc[(size_t)k * 64], wsrc[(size_t)(k + 1) * 64]); }
            bw[nt][ks] = __builtin_bit_cast(bf16x8, (u32x4){w[0], w[1], w[2], w[3]}); } }
    float brg[2], big[2], sp[2];
#pragma unroll
    for (int cc = 0; cc < 2; ++cc) { const int ch = cho + 16 * cc + fr; brg[cc] = a.in[I_BRG][l * DM + ch]; big[cc] = a.in[I_BIG][l * DM + ch];
        sp[cc] = 8.0f * log1pf(expf(-a.in[I_LAM][l * DM + ch])); }
    const int cp = tid & 31, tg = tid >> 5; const int cch = chb + 2 * cp;
    float cw[4][2], cb[2];
#pragma unroll
    for (int j = 0; j < 4; ++j) { cw[j][0] = a.in[I_CONVW][(l * 4 + j) * DM + cch]; cw[j][1] = a.in[I_CONVW][(l * 4 + j) * DM + cch + 1]; }
    cb[0] = a.in[I_CONVB][l * DM + cch]; cb[1] = a.in[I_CONVB][l * DM + cch + 1];
    if (tid < 64) carry[tid] = 0.f;
    for (int tile = 0; tile < SEQ / 128; ++tile) {
        const int t0 = tile * 128, par = tile & 1;
        {
            float xv[11][2];
#pragma unroll
            for (int j = 0; j < 11; ++j) { const int t = t0 + 8 * tg - 3 + j; unsigned w = 0u; if (t >= 0) w = *(const unsigned*)(P + (size_t)(row0 + t) * INW + C_LX + cch); xv[j][0] = bf_lo(w); xv[j][1] = bf_hi(w); }
#pragma unroll
            for (int i = 0; i < 8; ++i) { float x0 = cb[0], x1 = cb[1];
#pragma unroll
                for (int j = 0; j < 4; ++j) { x0 += cw[j][0] * xv[i + j][0]; x1 += cw[j][1] * xv[i + j][1]; }
                const int tt = 8 * tg + i;
                *(LAS unsigned*)(Abuf + tt * LRU_A_PITCH + 4 * cp) = pk2(x0, x1);
                if ((cp >> 4) == half) { xcf[tt * LRU_XF_PITCH + 2 * (cp & 15)] = x0; xcf[tt * LRU_XF_PITCH + 2 * (cp & 15) + 1] = x1; } }
        }
        LDS_WAIT(); __syncthreads();
        f32x4 acc[4];
#pragma unroll
        for (int nt = 0; nt < 4; ++nt) acc[nt] = (f32x4){0.f, 0.f, 0.f, 0.f};
#pragma unroll
        for (int ks = 0; ks < 2; ++ks) { const bf16x8 af = *(const LAS bf16x8*)(Abuf + (16 * wave + fr) * LRU_A_PITCH + 64 * ks + 16 * q);
#pragma unroll
            for (int nt = 0; nt < 4; ++nt) acc[nt] = __builtin_amdgcn_mfma_f32_16x16x32_bf16(af, bw[nt][ks], acc[nt], 0, 0, 0); }
        bf16_t gt[2][4];
#pragma unroll
        for (int cc = 0; cc < 2; ++cc)
#pragma unroll
            for (int i = 0; i < 4; ++i) gt[cc][i] = P[(size_t)(row0 + t0 + 16 * wave + 4 * q + i) * INW + C_LG + cho + 16 * cc + fr];
        float A_[2][4], H_[2][4], Ae[2], He[2];
#pragma unroll
        for (int cc = 0; cc < 2; ++cc) {
            float av[4], bv[4];
#pragma unroll
            for (int i = 0; i < 4; ++i) { const int tt = 16 * wave + 4 * q + i;
                const float r = sigm(acc[cc][i] + brg[cc]), ig = sigm(acc[cc + 2][i] + big[cc]);
                const float la = -r * sp[cc];
                av[i] = expf(la); const float mult = sqrtf(-expm1f(2.0f * la));
                bv[i] = mult * ig * xcf[tt * LRU_XF_PITCH + 16 * cc + fr]; }
            H_[cc][0] = bv[0]; A_[cc][0] = av[0];
#pragma unroll
            for (int i = 1; i < 4; ++i) { H_[cc][i] = av[i] * H_[cc][i - 1] + bv[i]; A_[cc][i] = av[i] * A_[cc][i - 1]; }
            float Ag = A_[cc][3], Hg = H_[cc][3];
            float t = __shfl_up(Ag, 16), u = __shfl_up(Hg, 16); if (q >= 1) { Hg = Ag * u + Hg; Ag = Ag * t; }
            t = __shfl_up(Ag, 32); u = __shfl_up(Hg, 32); if (q >= 2) { Hg = Ag * u + Hg; Ag = Ag * t; }
            t = __shfl_up(Ag, 16); u = __shfl_up(Hg, 16); Ae[cc] = q ? t : 1.0f; He[cc] = q ? u : 0.0f;
            if (q == 3) { wagg[(wave * 32 + 16 * cc + fr) * 2] = Ag; wagg[(wave * 32 + 16 * cc + fr) * 2 + 1] = Hg; }
        }
        LDS_WAIT(); __syncthreads();
#pragma unroll
        for (int cc = 0; cc < 2; ++cc) { const int c = 16 * cc + fr;
            float hin = carry[par * 32 + c];
            for (int w2 = 0; w2 < wave; ++w2) hin = wagg[(w2 * 32 + c) * 2] * hin + wagg[(w2 * 32 + c) * 2 + 1];
            const float hl = Ae[cc] * hin + He[cc];
#pragma unroll
            for (int i = 0; i < 4; ++i) { const float hv = A_[cc][i] * hl + H_[cc][i];
                if (i == 3 && wave == 7 && q == 3) carry[(par ^ 1) * 32 + c] = hv;
                const float gx = bf2f(gt[cc][i]); const float uu = 0.7978845608028654f * (gx + 0.044715f * gx * gx * gx);
                const float yv = hv * gx * sigm(2.0f * uu);
                Ya[(size_t)(row0 + t0 + 16 * wave + 4 * q + i) * DM + cho + c] = (bf16_t)f2bf(yv); } }
    }
    LDS_WAIT(); __syncthreads();
}

__device__ __forceinline__ void attn_item(const bf16_t* __restrict__ P, bf16_t* __restrict__ Y, int row0, int qcol, int kcol, int vcol, int ycol, int tq,
                                          int a0, int nA, int r4, int nB, float sink2, bool has_sink, LAS unsigned char* vb, int lane) {
    const int r = lane & 31, h = lane >> 5;
    constexpr float CS = 0.125f * LOG2E;
    bf16x8 qf[4];
    { const bf16_t* qp = P + (size_t)(row0 + tq) * INW + qcol + 8 * h;
#pragma unroll
      for (int ks = 0; ks < 4; ++ks) qf[ks] = *(const bf16x8*)(qp + 16 * ks); }
    f32x16 o0, o1;
#pragma unroll
    for (int i = 0; i < 16; ++i) { o0[i] = 0.f; o1[i] = 0.f; }
    float m = -1e30f, lsum = 0.f;
    const int nT = nA + nB;
    bf16x8 kf[4], vr[4];
    const int vrow = lane >> 3, vc = lane & 7;
#define ATT_PARAMS(ti, kt0, kst) do { if ((ti) < nA) { kt0 = a0 + 32 * (ti); kst = 1; } else { kt0 = r4 + 128 * ((ti) - nA); kst = 4; } } while (0)
#define ATT_LOAD(ti) do { int kt0_, kst_; ATT_PARAMS(ti, kt0_, kst_); \
        const bf16_t* kp_ = P + (size_t)(row0 + kt0_ + kst_ * r) * INW + kcol + 8 * h; \
        _Pragma("unroll") for (int ks = 0; ks < 4; ++ks) kf[ks] = *(const bf16x8*)(kp_ + 16 * ks); \
        _Pragma("unroll") for (int i = 0; i < 4; ++i) vr[i] = *(const bf16x8*)(P + (size_t)(row0 + kt0_ + kst_ * (8 * i + vrow)) * INW + vcol + 8 * vc); } while (0)
    ATT_LOAD(0);
    const int vwoff = (vc >> 2) * 2048 + vrow * 64 + (vc & 3) * 16;
    const int g = lane >> 4, idx = lane & 15;
    const int vroff = (4 * h + (idx >> 2)) * 64 + 32 * (g & 1) + 8 * (idx & 3);
    for (int ti = 0; ti < nT; ++ti) {
        int kt0, kst; ATT_PARAMS(ti, kt0, kst);
        const bool mode1 = ti >= nA;
        asm volatile("" ::: "memory");
#pragma unroll
        for (int i = 0; i < 4; ++i) *(LAS bf16x8*)(vb + vwoff + i * 512) = vr[i];
        bf16x8 kc[4];
#pragma unroll
        for (int ks = 0; ks < 4; ++ks) kc[ks] = kf[ks];
        if (ti + 1 < nT) ATT_LOAD(ti + 1);
        f32x16 s;
#pragma unroll
        for (int i = 0; i < 16; ++i) s[i] = 0.f;
#pragma unroll
        for (int ks = 0; ks < 4; ++ks) s = __builtin_amdgcn_mfma_f32_32x32x16_bf16(kc[ks], qf[ks], s, 0, 0, 0);
        float mx = -1e30f;
#pragma unroll
        for (int i = 0; i < 16; ++i) { const int n = (i & 3) + 8 * (i >> 2) + 4 * h; const int dlt = tq - (kt0 + kst * n);
            float lw;
            if (!mode1) lw = (dlt >= 0 && dlt <= 128) ? 0.f : -__builtin_inff();
            else { const int w = (dlt >= 0) ? ((dlt <= 512 ? 1 : 0) + ((dlt & 15) == 0 ? 1 : 0)) : 0; lw = (w == 0) ? -__builtin_inff() : (w == 2 ? 1.0f : 0.f); }
            s[i] = s[i] * CS + lw; mx = fmaxf(mx, s[i]); }
        mx = fmaxf(mx, __shfl_xor(mx, 32));
        const float mn = fmaxf(m, mx); const float alpha = ex2(m - mn); m = mn;
        float rs = 0.f;
#pragma unroll
        for (int i = 0; i < 16; ++i) { s[i] = ex2(s[i] - mn); rs += s[i]; }
        lsum = lsum * alpha + rs;
#pragma unroll
        for (int i = 0; i < 16; ++i) { o0[i] *= alpha; o1[i] *= alpha; }
        bf16x8 pf[2];
#pragma unroll
        for (int sb = 0; sb < 2; ++sb) { u32x4 w; w.x = pk2(s[8 * sb + 0], s[8 * sb + 1]); w.y = pk2(s[8 * sb + 2], s[8 * sb + 3]); w.z = pk2(s[8 * sb + 4], s[8 * sb + 5]); w.w = pk2(s[8 * sb + 6], s[8 * sb + 7]);
            pf[sb] = __builtin_bit_cast(bf16x8, w); }
        LDS_WAIT();
#pragma unroll
        for (int dt = 0; dt < 2; ++dt)
#pragma unroll
            for (int sb = 0; sb < 2; ++sb) {
                const s16x4 v0 = __builtin_bit_cast(s16x4, __builtin_amdgcn_ds_read_tr16_b64_v4i16((LAS s16x4*)(vb + vroff + dt * 2048 + sb * 1024)));
                const s16x4 v1 = __builtin_bit_cast(s16x4, __builtin_amdgcn_ds_read_tr16_b64_v4i16((LAS s16x4*)(vb + vroff + dt * 2048 + sb * 1024 + 512)));
                const bf16x8 vf = (bf16x8){v0[0], v0[1], v0[2], v0[3], v1[0], v1[1], v1[2], v1[3]};
                if (dt == 0) o0 = __builtin_amdgcn_mfma_f32_32x32x16_bf16(vf, pf[sb], o0, 0, 0, 0);
                else o1 = __builtin_amdgcn_mfma_f32_32x32x16_bf16(vf, pf[sb], o1, 0, 0, 0);
            }
        asm volatile("" ::: "memory");
    }
#undef ATT_LOAD
#undef ATT_PARAMS
    lsum += __shfl_xor(lsum, 32);
    float scale;
    if (has_sink) { const float mf = fmaxf(m, sink2); const float al = ex2(m - mf); scale = al * rcpf_(lsum * al + ex2(sink2 - mf)); }
    else scale = rcpf_(lsum);
    bf16_t* yp = Y + (size_t)(row0 + tq) * DM + ycol + 4 * h;
#pragma unroll
    for (int g4 = 0; g4 < 4; ++g4) {
        u32x2 w0; w0.x = pk2(o0[4 * g4] * scale, o0[4 * g4 + 1] * scale); w0.y = pk2(o0[4 * g4 + 2] * scale, o0[4 * g4 + 3] * scale); *(u32x2*)(yp + 8 * g4) = w0;
        u32x2 w1; w1.x = pk2(o1[4 * g4] * scale, o1[4 * g4 + 1] * scale); w1.y = pk2(o1[4 * g4 + 2] * scale, o1[4 * g4 + 3] * scale); *(u32x2*)(yp + 32 + 8 * g4) = w1;
    }
}

__device__ __forceinline__ void phase_mixer(const Args& a, int l, LAS unsigned char* lds, const bf16_t* P, bf16_t* Yb, int tid, int wave, int lane) {
    for (int item = blockIdx.x; item < SEQ_PER_CH * 32; item += gridDim.x) lru_item(a, l, item, lds, P, Yb, tid, wave, lane);
    LAS unsigned char* vb = lds + wave * 4096;
    const int W = blockIdx.x * 8 + wave, NW = gridDim.x * 8;
    for (int it = W; it < SEQ_PER_CH * 16 * 64; it += NW) {
        const int bl = it >> 10, hq = (it >> 6) & 15, blk = it & 63; const int t0 = 32 * blk;
        const int a0 = t0 >= 128 ? t0 - 128 : 0, nA = (t0 + 32 - a0) >> 5;
        attn_item(P, Yb + (size_t)MC * DM, bl * SEQ, C_QB + 64 * hq, C_KB + 64 * (hq >> 2), C_VB + 64 * (hq >> 2), 64 * hq, t0 + (lane & 31), a0, nA, 0, 0,
                  a.in[I_SINK][l * 16 + hq] * LOG2E, true, vb, lane);
    }
    for (int wk = W; wk < SEQ_PER_CH * 16 * 16; wk += NW) {
        const int bl = wk >> 8, hq = (wk >> 4) & 15, pg = wk & 15, r4 = pg & 3, aa = pg >> 2;
#pragma unroll 1
        for (int k = 0; k < 4; ++k) {
            const int blk = (k == 0) ? aa : (k == 1) ? 7 - aa : (k == 2) ? 8 + aa : 15 - aa; const int T0 = 128 * blk;
            const int a0 = T0 >= 128 ? T0 - 128 : 0, nA = (T0 + 128 - a0) >> 5, nB = blk + 1;
            attn_item(P, Yb + (size_t)2 * MC * DM, bl * SEQ, C_QC + 64 * hq, C_KC + 64 * hq, C_VC + 64 * hq, 64 * hq, T0 + r4 + 4 * (lane & 31), a0, nA, r4, nB, 0.f, false, vb, lane);
        }
    }
}

__global__ void __launch_bounds__(512, 2) mega_fwd(Args a) {
    extern __shared__ __attribute__((aligned(16))) unsigned char lds_raw[];
    LAS unsigned char* lds = (LAS unsigned char*)lds_raw;
    const int tid = threadIdx.x, lane = tid & 63, wave = __builtin_amdgcn_readfirstlane(tid >> 6);
    const int G = gridDim.x, gw = blockIdx.x * 8 + wave, NGW = G * 8;
    unsigned char* ws = a.ws;
    bf16_t* XB = (bf16_t*)(ws + WS_XB); bf16_t* PROJ = (bf16_t*)(ws + WS_PROJ); bf16_t* YB = (bf16_t*)(ws + WS_Y); bf16_t* MRG = (bf16_t*)(ws + WS_MRG); bf16_t* HB = (bf16_t*)(ws + WS_H);
    cg::grid_group grid = cg::this_grid();
    const int tid0 = tid, lane0 = lane;
#pragma unroll 1
    for (int ph = a.ph_lo; ph < a.ph_hi; ++ph) {
        if (ph > a.ph_lo) grid.sync();
        int tid = tid0, lane = lane0; asm volatile("" : "+v"(tid), "+v"(lane));
        if (ph == 0) { phase_init(a.in[I_X], XB, gw, NGW, lane); continue; }
        const int qq = ph - 1, l = qq / 17, rr = qq % 17;
        if (rr == 0) { phase_weights(a, l, lds, gw, NGW, wave, lane); continue; }
        const int c = (rr - 1) >> 3, st = (rr - 1) & 7;
        const size_t crow = (size_t)c * MC;
        float* xres = a.out + crow * DM; bf16_t* xb = XB + crow * DM;
        if (st == 0 && (PH_MASK & 1)) {
            pg8::StaticOrder S; S.init(MC, INW, G, (int)blockIdx.x); pg8::EpiProj E{PROJ, INW};
            pg8::gemm_phase(lds, xb, DM, (const bf16_t*)(ws + WS_WIN), DM, S, E, tid);
        } else if (st == 1 && (PH_MASK & 2)) {
            phase_mixer(a, l, lds, PROJ, YB, tid, wave, lane);
        } else if (st == 2 && (PH_MASK & 4)) {
            pg8::BranchOrder S; S.init(G, (int)blockIdx.x); pg8::EpiBranch E{PROJ, MRG};
            pg8::gemm_phase(lds, YB, DM, (const bf16_t*)(ws + WS_WBR), DM, S, E, tid);
        } else if (st == 3 && (PH_MASK & 8)) {
            pg8::StaticOrder S; S.init(MC, DM, G, (int)blockIdx.x); pg8::EpiResid E{(l == 0 ? a.in[I_X] : a.out) + crow * DM, xres};
            pg8::gemm_phase(lds, MRG, DM, (const bf16_t*)(ws + WS_WOUT), DM, S, E, tid);
        } else if (st == 4 && (PH_MASK & 16)) {
            phase_ln(xres, xb, a.in[I_LN1G] + l * DM, a.in[I_LN1B] + l * DM, MC, gw, NGW, lane);
        } else if (st == 5 && (PH_MASK & 32)) {
            pg8::StaticOrder S; S.init(MC, FF2, G, (int)blockIdx.x); pg8::EpiSwiGLU E{HB};
            pg8::gemm_phase(lds, xb, DM, (const bf16_t*)(ws + WS_WF1), DM, S, E, tid);
        } else if (st == 6 && (PH_MASK & 64)) {
            pg8::StaticOrder S; S.init(MC, DM, G, (int)blockIdx.x); pg8::EpiResid E{xres, xres};
            pg8::gemm_phase(lds, HB, FFH, (const bf16_t*)(ws + WS_WF2), FFH, S, E, tid);
        } else if (PH_MASK & 128) {
            phase_ln(xres, xb, a.in[I_LN2G] + l * DM, a.in[I_LN2B] + l * DM, MC, gw, NGW, lane);
        }
    }
}

extern "C" void kernel_launch(void* const* d_in, const int* in_sizes, int n_in, void* d_out, int out_size, void* d_ws, size_t ws_size, hipStream_t stream) {
    static int grid = 0;
    if (grid == 0) {
        if (n_in != 18 || out_size != MTOT * DM || ws_size < WS_END) { fprintf(stderr, "kernel_launch: unexpected shapes (n_in %d out %d ws %zu)\n", n_in, out_size, ws_size); grid = -1; return; }
        int dev = 0, cus = 0, per_cu = 0;
        hipGetDevice(&dev); hipDeviceGetAttribute(&cus, hipDeviceAttributeMultiprocessorCount, dev);
        if (hipFuncSetAttribute((const void*)mega_fwd, hipFuncAttributeMaxDynamicSharedMemorySize, LDS_BYTES) != hipSuccess) { fprintf(stderr, "kernel_launch: hipFuncSetAttribute failed\n"); grid = -1; return; }
        if (hipOccupancyMaxActiveBlocksPerMultiprocessor(&per_cu, (const void*)mega_fwd, 512, LDS_BYTES) != hipSuccess || per_cu < 1) { fprintf(stderr, "kernel_launch: occupancy query says %d\n", per_cu); per_cu = 1; }
        (void)hipGetLastError();
        grid = cus * per_cu;
    }
    if (grid < 0) return;
    Args a{};
    for (int i = 0; i < 18; ++i) a.in[i] = (const float*)d_in[i];
    a.out = (float*)d_out; a.ws = (unsigned char*)d_ws;
#if MK_MULTI
    for (int ph = 0; ph < NPH; ++ph) { a.ph_lo = ph; a.ph_hi = ph + 1; hipLaunchKernelGGL(mega_fwd, dim3(grid), dim3(512), LDS_BYTES, stream, a); }
#else
    a.ph_lo = 0; a.ph_hi = NPH;
    void* args[] = {&a};
    hipError_t e = hipLaunchCooperativeKernel((const void*)mega_fwd, dim3(grid), dim3(512), args, LDS_BYTES, stream);
    if (e != hipSuccess) fprintf(stderr, "cooperative launch failed: %s (grid %d)\n", hipGetErrorString(e), grid);
#endif
}
```

```cpp
#include <hip/hip_runtime.h>
#include <hip/hip_cooperative_groups.h>
#include <cstdio>
namespace cg = cooperative_groups;

#ifndef MK_MULTI
#define MK_MULTI 0
#endif

#ifndef PROBE_ST
#define PROBE_ST -1
#define PROBE_REP 0
#endif
#ifndef PH_MASK
#define PH_MASK 255
#endif
#define LAS __attribute__((address_space(3)))
typedef unsigned short bf16_t;
typedef short bf16x8 __attribute__((ext_vector_type(8)));
typedef short s16x4 __attribute__((ext_vector_type(4)));
typedef float f32x4 __attribute__((ext_vector_type(4)));
typedef float f32x16 __attribute__((ext_vector_type(16)));
typedef unsigned u32x4 __attribute__((ext_vector_type(4)));
typedef unsigned u32x2 __attribute__((ext_vector_type(2)));

constexpr int DM = 1024, SEQ = 2048, BATCH = 16, DEPTH = 4, INW = 9728, FFH = 2816, FF2 = 5632;
constexpr int NCH = 2, MC = 16384, SEQ_PER_CH = 8, MTOT = BATCH * SEQ;
constexpr int C_LX = 0, C_LG = 1024, C_QB = 2048, C_KB = 3072, C_VB = 3328, C_QC = 3584, C_KC = 4608, C_VC = 5632, C_GATE = 6656;
constexpr float LN_EPS = 1e-5f;
constexpr float ALPHA = 1.681792830507429f;
constexpr float LOG2E = 1.4426950408889634f;
constexpr size_t MiB = 1u << 20;
constexpr size_t WS_WIN = 0, WS_WBR = 19 * MiB, WS_WOUT = 25 * MiB, WS_WF1 = 27 * MiB, WS_WF2 = 38 * MiB, WS_XB = 44 * MiB, WS_PROJ = 108 * MiB,
                 WS_Y = 412 * MiB, WS_MRG = 508 * MiB, WS_END = 540 * MiB, WS_H = WS_PROJ, WS_CTL = 604 * MiB  , WS_NEED = 605 * MiB;
constexpr int LDS_BYTES = 147456;
constexpr int NPH = 1 + DEPTH * 17;

__device__ __forceinline__ unsigned f2bf(float f) { unsigned u = __builtin_bit_cast(unsigned, f); return (u + 0x7fffu + ((u >> 16) & 1u)) >> 16; }
__device__ __forceinline__ unsigned pk2(float lo, float hi) { unsigned r; asm volatile("v_cvt_pk_bf16_f32 %0, %1, %2" : "=v"(r) : "v"(lo), "v"(hi)); return r; }
__device__ __forceinline__ float bf_lo(unsigned w) { return __builtin_bit_cast(float, w << 16); }
__device__ __forceinline__ float bf_hi(unsigned w) { return __builtin_bit_cast(float, w & 0xffff0000u); }
__device__ __forceinline__ float bf2f(bf16_t b) { return __builtin_bit_cast(float, ((unsigned)b) << 16); }
__device__ __forceinline__ float ex2(float x) { return __builtin_amdgcn_exp2f(x); }
__device__ __forceinline__ float rcpf_(float x) { return __builtin_amdgcn_rcpf(x); }
__device__ __forceinline__ float sigm(float x) { return rcpf_(1.0f + ex2(-x * LOG2E)); }
__device__ __forceinline__ float wave_sum(float v) {
#pragma unroll
    for (int o = 1; o < 64; o <<= 1) v += __shfl_xor(v, o);
    return v;
}
#define LDS_WAIT() asm volatile("s_waitcnt lgkmcnt(0)" ::: "memory")

namespace pg8 {
constexpr int BM = 256, BK = 64, HALF = 128, HTB = HALF * BK * 2, STAGE_BYTES = 8 * HTB, NXCD = 8, WGM = 8;
__host__ __device__ __forceinline__ int lds_byte(int r, int c) { const int st = (r >> 4) * 2 + (c >> 5), rr = r & 15, cc = c & 31, ob = rr * 64 + cc * 2; return st * 1024 + (ob ^ (((ob >> 9) & 1) << 5)); }
__host__ __device__ __forceinline__ void stage_rc(int b, int& R, int& C) { const int st = b / 1024, sb = b % 1024, swz = sb ^ (((sb >> 9) & 1) << 5); R = (st >> 1) * 16 + swz / 64; C = (st & 1) * 32 + (swz % 64) / 2; }
__host__ __device__ __forceinline__ int perm32(int rho) { const int n = rho >> 4, i = rho & 15; return 8 * (i >> 2) + 4 * n + (i & 3); }
struct Unit { int pm, pn; };
struct StaticOrder {
    int nM, nN, nwg, G, c;
    __device__ void init(int M, int N, int G_, int c_) { nM = M / BM; nN = N / BM; nwg = nM * nN; G = G_; c = c_; }
    __device__ bool next(int i, Unit& u) const {
        const long L = (long)i * G + c; if (L >= nwg) return false;
        int wgid = (int)L; { const int q = nwg / NXCD, r = nwg % NXCD, xcd = wgid % NXCD, off = wgid / NXCD; wgid = (xcd < r ? xcd * (q + 1) : r * (q + 1) + (xcd - r) * q) + off; }
        const int nig = WGM * nN, gid = wgid / nig, fm = gid * WGM, gsz = (nM - fm) < WGM ? (nM - fm) : WGM;
        u.pm = fm + ((wgid % nig) % gsz); u.pn = (wgid % nig) / gsz; return true;
    }
};
struct BranchOrder {
    StaticOrder so;
    __device__ void init(int G_, int c_) { so.init(MC, DM, G_, c_); }
    __device__ bool next(int i, Unit& u) const { const int t = i / 3, n = i - 3 * t; Unit b; if (!so.next(t, b)) return false; u.pm = n * (MC / BM) + b.pm; u.pn = n * (DM / BM) + b.pn; return true; }
};

typedef f32x4 Acc[2][2][4][2];

struct EpiProj {
    static constexpr bool PERM = true;
    bf16_t* O; int ldc;
    __device__ __forceinline__ bool operator()(Acc& acc, const Unit& u, int wr, int wc, int fr, int fq) const {
        const int row0 = u.pm * BM + wr * 64 + fr, col0 = u.pn * BM + wc * 32 + 8 * fq;
#pragma unroll
        for (int ai = 0; ai < 2; ++ai)
#pragma unroll
            for (int m = 0; m < 4; ++m) { bf16_t* rowp = O + (size_t)(row0 + ai * HALF + m * 16) * ldc + col0;
#pragma unroll
                for (int bj = 0; bj < 2; ++bj) { const f32x4 v0 = acc[ai][bj][m][0], v1 = acc[ai][bj][m][1];
                    u32x4 w; w.x = pk2(v0[0], v0[1]); w.y = pk2(v0[2], v0[3]); w.z = pk2(v1[0], v1[1]); w.w = pk2(v1[2], v1[3]);
                    *(u32x4*)(rowp + bj * HALF) = w; } }
        return false;
    }
};
struct EpiBranch {
    static constexpr bool PERM = true;
    const bf16_t* P; bf16_t* O;
    __device__ __forceinline__ bool operator()(Acc& acc, const Unit& u, int wr, int wc, int fr, int fq) const {
        const int n = u.pn >> 2, pn = u.pn & 3, pm = u.pm & 63;
        const int row0 = pm * BM + wr * 64 + fr, col0 = pn * BM + wc * 32 + 8 * fq;
#pragma unroll
        for (int ai = 0; ai < 2; ++ai)
#pragma unroll
            for (int m = 0; m < 4; ++m) { const int row = row0 + ai * HALF + m * 16;
#pragma unroll
                for (int bj = 0; bj < 2; ++bj) {
                    const bf16_t* gp = P + (size_t)row * INW + C_GATE + n * DM + col0 + bj * HALF;
                    const u32x4 ga = *(const u32x4*)gp; u32x4 gb = ga; if (n < 2) gb = *(const u32x4*)(gp + DM);
                    float fa[8], fb[8];
                    fa[0] = bf_lo(ga.x); fa[1] = bf_hi(ga.x); fa[2] = bf_lo(ga.y); fa[3] = bf_hi(ga.y); fa[4] = bf_lo(ga.z); fa[5] = bf_hi(ga.z); fa[6] = bf_lo(ga.w); fa[7] = bf_hi(ga.w);
                    fb[0] = bf_lo(gb.x); fb[1] = bf_hi(gb.x); fb[2] = bf_lo(gb.y); fb[3] = bf_hi(gb.y); fb[4] = bf_lo(gb.z); fb[5] = bf_hi(gb.z); fb[6] = bf_lo(gb.w); fb[7] = bf_hi(gb.w);
                    float v[8];
#pragma unroll
                    for (int j = 0; j < 8; ++j) { const float da = 1.0f + ex2(-fa[j] * LOG2E); const float nb = (n < 2) ? (1.0f + ex2(-fb[j] * LOG2E)) : 1.0f;
                        const float f = nb * rcpf_(da); v[j] = acc[ai][bj][m][j >> 2][j & 3] * f; }
                    acc[ai][bj][m][0] = (f32x4){v[0], v[1], v[2], v[3]}; acc[ai][bj][m][1] = (f32x4){v[4], v[5], v[6], v[7]};
                    if (n == 2) { u32x4 w; w.x = pk2(v[0], v[1]); w.y = pk2(v[2], v[3]); w.z = pk2(v[4], v[5]); w.w = pk2(v[6], v[7]);
                        *(u32x4*)(O + (size_t)row * DM + col0 + bj * HALF) = w; }
                } }
        return n < 2;
    }
};
struct EpiResid {
    static constexpr bool PERM = false;
    const float* src; float* dst;
    __device__ __forceinline__ bool operator()(Acc& acc, const Unit& u, int wr, int wc, int fr, int fq) const {
        const int row0 = u.pm * BM + wr * 64 + fr, col0 = u.pn * BM + wc * 32 + 4 * fq;
#pragma unroll
        for (int ai = 0; ai < 2; ++ai)
#pragma unroll
            for (int m = 0; m < 4; ++m) { const size_t off = (size_t)(row0 + ai * HALF + m * 16) * DM + col0;
#pragma unroll
                for (int bj = 0; bj < 2; ++bj)
#pragma unroll
                    for (int n = 0; n < 2; ++n) { const f32x4 bs = *(const f32x4*)(src + off + bj * HALF + n * 16); *(f32x4*)(dst + off + bj * HALF + n * 16) = bs * ALPHA + acc[ai][bj][m][n]; } }
        return false;
    }
};
struct EpiSwiGLU {
    static constexpr bool PERM = true;
    bf16_t* H;
    __device__ __forceinline__ bool operator()(Acc& acc, const Unit& u, int wr, int wc, int fr, int fq) const {
        const int row0 = u.pm * BM + wr * 64 + fr, col0 = u.pn * 128 + wc * 16 + 4 * fq;
#pragma unroll
        for (int ai = 0; ai < 2; ++ai)
#pragma unroll
            for (int m = 0; m < 4; ++m) { bf16_t* rowp = H + (size_t)(row0 + ai * HALF + m * 16) * FFH + col0;
#pragma unroll
                for (int bj = 0; bj < 2; ++bj) { const f32x4 a = acc[ai][bj][m][0], b = acc[ai][bj][m][1]; float v[4];
#pragma unroll
                    for (int j = 0; j < 4; ++j) v[j] = a[j] * sigm(a[j]) * b[j];
                    u32x2 w; w.x = pk2(v[0], v[1]); w.y = pk2(v[2], v[3]); *(u32x2*)(rowp + bj * 64) = w; } }
        return false;
    }
};

template <class Epi, class Sched>
__device__ __forceinline__ void gemm_phase(LAS unsigned char* lds, const bf16_t* Ab, int lda, const bf16_t* Btb, int K, const Sched& S, const Epi& E, const int tid) {
    const int wid = __builtin_amdgcn_readfirstlane(tid >> 6), lane = tid & 63, wr = wid >> 2, wc = wid & 3, fr = lane & 15, fq = lane >> 4;
    const int nt = K / BK;
    unsigned voffA[2], voffB[2];
#pragma unroll
    for (int i = 0; i < 2; ++i) { int R, C; stage_rc(tid * 16 + i * 8192, R, C); const int Rb = Epi::PERM ? ((R & ~31) + perm32(R & 31)) : R;
        voffA[i] = (unsigned)(R * lda + C) * 2u; voffB[i] = (unsigned)(Rb * K + C) * 2u; }
    const size_t kstep = (size_t)(BK * 2);
    const size_t hstepA = (size_t)HALF * lda * 2, tstepA = 2 * hstepA, hstepB = (size_t)HALF * K * 2, tstepB = 2 * hstepB;
    const unsigned ldsw = (unsigned)wid * 1024u;
    const int aoff = lds_byte(wr * 64 + fr, fq * 8), boff = lds_byte(wc * 32 + fr, fq * 8);
#define PG8_SA(b, h) (((b) * 2 + (h)) * HTB)
#define PG8_SB(b, h) ((4 + (b) * 2 + (h)) * HTB)
#define PG8_STAGE(bufoff, gbase, voff) do { _Pragma("unroll") for (int _i = 0; _i < 2; ++_i) \
        __builtin_amdgcn_global_load_lds((const unsigned*)((const char*)(gbase) + (voff)[_i]), (LAS unsigned*)(lds + (bufoff) + ldsw + _i * 8192), 16, 0, 0); } while (0)
#define PG8_LDA(dst, b, h) do { _Pragma("unroll") for (int m = 0; m < 4; ++m) _Pragma("unroll") for (int k = 0; k < 2; ++k) dst[m][k] = *(const LAS bf16x8*)(lds + PG8_SA(b, h) + aoff + m * 2048 + k * 1024); } while (0)
#define PG8_LDB(dst, b, h) do { _Pragma("unroll") for (int n = 0; n < 2; ++n) _Pragma("unroll") for (int k = 0; k < 2; ++k) dst[n][k] = *(const LAS bf16x8*)(lds + PG8_SB(b, h) + boff + n * 2048 + k * 1024); } while (0)
#define PG8_MMA(ai, bj, At, Bt) do { __builtin_amdgcn_s_setprio(1); _Pragma("unroll") for (int m = 0; m < 4; ++m) _Pragma("unroll") for (int n = 0; n < 2; ++n) _Pragma("unroll") for (int k = 0; k < 2; ++k) \
        acc[ai][bj][m][n] = __builtin_amdgcn_mfma_f32_16x16x32_bf16(Bt[n][k], At[m][k], acc[ai][bj][m][n], 0, 0, 0); __builtin_amdgcn_s_setprio(0); } while (0)
#define PG8_WAIT_V(n) asm volatile("s_waitcnt vmcnt(" #n ")" ::: "memory")
#define PG8_WAIT_L(n) asm volatile("s_waitcnt lgkmcnt(" #n ")" ::: "memory")
#define PG8_BAR __builtin_amdgcn_s_barrier()
#define PG8_SCHED __builtin_amdgcn_sched_barrier(0)
    Unit cur, nxt; int ui = 0;
    if (!S.next(0, cur)) return;
    Acc acc;
#pragma unroll
    for (int a = 0; a < 2; ++a)
#pragma unroll
        for (int b = 0; b < 2; ++b)
#pragma unroll
            for (int m = 0; m < 4; ++m)
#pragma unroll
                for (int n = 0; n < 2; ++n) acc[a][b][m][n] = (f32x4){0.f, 0.f, 0.f, 0.f};
    bf16x8 At[4][2], B0[2][2], B1[2][2];
    const char* cA = (const char*)Ab + (size_t)cur.pm * tstepA; const char* cB = (const char*)Btb + (size_t)cur.pn * tstepB;
    PG8_STAGE(PG8_SB(0, 0), cB, voffB); PG8_STAGE(PG8_SB(0, 1), cB + hstepB, voffB); PG8_STAGE(PG8_SA(0, 0), cA, voffA); PG8_STAGE(PG8_SA(0, 1), cA + hstepA, voffA);
    if (wr == 1) PG8_BAR;
    PG8_WAIT_V(2); PG8_BAR;
    PG8_STAGE(PG8_SB(1, 0), cB + kstep, voffB); PG8_STAGE(PG8_SA(1, 0), cA + kstep, voffA); PG8_STAGE(PG8_SB(1, 1), cB + hstepB + kstep, voffB);
    PG8_WAIT_V(6); PG8_BAR;
    for (;;) {
        const bool has_next = S.next(ui + 1, nxt);
        const char* nA = has_next ? (const char*)Ab + (size_t)nxt.pm * tstepA : cA; const char* nB = has_next ? (const char*)Btb + (size_t)nxt.pn * tstepB : cB;
        for (int t = 0; t < nt; t += 2) {
            const bool last = (t == nt - 2);
            const char* a1 = cA + (size_t)(t + 1) * kstep;
            const char* a2 = last ? nA : cA + (size_t)(t + 2) * kstep; const char* b2 = last ? nB : cB + (size_t)(t + 2) * kstep;
            const char* a3 = a2 + kstep; const char* b3 = b2 + kstep;
            PG8_LDB(B0, 0, 0); PG8_LDB(B1, 0, 1); PG8_SCHED; PG8_LDA(At, 0, 0); PG8_STAGE(PG8_SA(1, 1), a1 + hstepA, voffA);
            PG8_WAIT_V(8); PG8_WAIT_L(0); PG8_BAR; PG8_MMA(0, 0, At, B0); PG8_MMA(0, 1, At, B1); PG8_BAR; PG8_SCHED;
            PG8_LDA(At, 0, 1); PG8_STAGE(PG8_SB(0, 0), b2, voffB); PG8_STAGE(PG8_SB(0, 1), b2 + hstepB, voffB); PG8_STAGE(PG8_SA(0, 0), a2, voffA);
            PG8_WAIT_V(8); PG8_WAIT_L(0); PG8_BAR; PG8_MMA(1, 0, At, B0); PG8_MMA(1, 1, At, B1); PG8_BAR; PG8_SCHED;
            PG8_LDB(B0, 1, 0); PG8_LDB(B1, 1, 1); PG8_SCHED; PG8_LDA(At, 1, 0); PG8_STAGE(PG8_SA(0, 1), a2 + hstepA, voffA);
            PG8_WAIT_V(8); PG8_WAIT_L(0); PG8_BAR; PG8_MMA(0, 0, At, B0); PG8_MMA(0, 1, At, B1); PG8_BAR; PG8_SCHED;
            PG8_LDA(At, 1, 1); PG8_STAGE(PG8_SB(1, 0), b3, voffB); PG8_STAGE(PG8_SB(1, 1), b3 + hstepB, voffB); PG8_STAGE(PG8_SA(1, 0), a3, voffA);
            PG8_WAIT_V(8); PG8_WAIT_L(0); PG8_BAR; PG8_MMA(1, 0, At, B0); PG8_MMA(1, 1, At, B1); PG8_BAR; PG8_SCHED;
        }
        if (wr == 0) PG8_BAR;
        const bool keep = E(acc, cur, wr, wc, fr, fq);
        if (!has_next) break;
        if (!keep) {
#pragma unroll
            for (int a = 0; a < 2; ++a)
#pragma unroll
                for (int b = 0; b < 2; ++b)
#pragma unroll
                    for (int m = 0; m < 4; ++m)
#pragma unroll
                        for (int n = 0; n < 2; ++n) acc[a][b][m][n] = (f32x4){0.f, 0.f, 0.f, 0.f};
        }
        cur = nxt; cA = nA; cB = nB; ++ui;
        if (wr == 1) PG8_BAR;
    }
    PG8_WAIT_V(0);
    PG8_BAR;
#undef PG8_SA
#undef PG8_SB
#undef PG8_STAGE
#undef PG8_LDA
#undef PG8_LDB
#undef PG8_MMA
#undef PG8_WAIT_V
#undef PG8_WAIT_L
#undef PG8_BAR
#undef PG8_SCHED
}
}

struct Args { const float* in[18]; float* out; unsigned char* ws; int ph_lo, ph_hi; };
enum { I_X = 0, I_WIN, I_CONVW, I_CONVB, I_WRG, I_BRG, I_WIG, I_BIG, I_LAM, I_SINK, I_WBR, I_WOUT, I_LN1G, I_LN1B, I_WF1, I_WF2, I_LN2G, I_LN2B };

template <int MODE>
__device__ __forceinline__ void transpose_item(const float* W, int K, int N, bf16_t* WT, int row_off, LAS float* scr, int item, int lane) {
    const int nblk = N / 32, kb = item / nblk, nb = item % nblk, k0 = 64 * kb, n0 = 32 * nb;
#pragma unroll 8
    for (int i = 0; i < 32; ++i) { const int kk = 2 * i + (lane >> 5); scr[kk * 33 + (lane & 31)] = W[(size_t)(k0 + kk) * N + n0 + (lane & 31)]; }
    LDS_WAIT();
    const int c = lane & 7;
#pragma unroll
    for (int j = 0; j < 4; ++j) { const int n = (lane >> 3) + 8 * j; const LAS float* s = scr + (8 * c) * 33 + n;
        u32x4 o; o.x = pk2(s[0 * 33], s[1 * 33]); o.y = pk2(s[2 * 33], s[3 * 33]); o.z = pk2(s[4 * 33], s[5 * 33]); o.w = pk2(s[6 * 33], s[7 * 33]);
        int row = n0 + n;
        if (MODE == 1) { const int sgl = row >= FFH ? 1 : 0; const int jj = row - sgl * FFH; row = 8 * (jj >> 2) + 4 * sgl + (jj & 3); }
        *(u32x4*)(WT + (size_t)(row_off + row) * K + k0 + 8 * c) = o; }
    LDS_WAIT();
}
__device__ __forceinline__ void phase_weights(const Args& a, int l, unsigned char* ws, LAS unsigned char* lds, int gw, int NGW, int wave, int lane) {
    LAS float* scr = (LAS float*)(lds + wave * 16384);
    constexpr int I_IN = 16 * (INW / 32), I_BR1 = 16 * 32, I_OUT = 16 * 32, I_F1 = 16 * (FF2 / 32), I_F2 = (FFH / 64) * 32;
    constexpr int NIT = I_IN + 3 * I_BR1 + I_OUT + I_F1 + I_F2;
    for (int it = gw; it < NIT; it += NGW) {
        int r = it;
        if (r < I_IN) { transpose_item<0>(a.in[I_WIN] + (size_t)l * DM * INW, DM, INW, (bf16_t*)(ws + WS_WIN), 0, scr, r, lane); continue; } r -= I_IN;
        if (r < 3 * I_BR1) { const int n = r / I_BR1; transpose_item<0>(a.in[I_WBR] + ((size_t)l * 3 + n) * DM * DM, DM, DM, (bf16_t*)(ws + WS_WBR), n * DM, scr, r - n * I_BR1, lane); continue; } r -= 3 * I_BR1;
        if (r < I_OUT) { transpose_item<0>(a.in[I_WOUT] + (size_t)l * DM * DM, DM, DM, (bf16_t*)(ws + WS_WOUT), 0, scr, r, lane); continue; } r -= I_OUT;
        if (r < I_F1) { transpose_item<1>(a.in[I_WF1] + (size_t)l * DM * FF2, DM, FF2, (bf16_t*)(ws + WS_WF1), 0, scr, r, lane); continue; } r -= I_F1;
        transpose_item<0>(a.in[I_WF2] + (size_t)l * FFH * DM, FFH, DM, (bf16_t*)(ws + WS_WF2), 0, scr, r, lane);
    }
}

__device__ __forceinline__ void phase_ln(const float* zx, float* xo, bf16_t* xb, const float* g, const float* b, int nrows, int gw, int NGW, int lane) {
    f32x4 gv[4], bv[4];
#pragma unroll
    for (int j = 0; j < 4; ++j) { gv[j] = *((const f32x4*)g + lane + 64 * j); bv[j] = *((const f32x4*)b + lane + 64 * j); }
    for (int m = gw; m < nrows; m += NGW) {
        const f32x4* xr = (const f32x4*)(zx + (size_t)m * DM) + lane; f32x4* xw = (f32x4*)(xo + (size_t)m * DM) + lane;
        f32x4 v[4]; float s = 0.f;
#pragma unroll
        for (int j = 0; j < 4; ++j) { v[j] = xr[64 * j]; s += (v[j].x + v[j].y) + (v[j].z + v[j].w); }
        const float mean = wave_sum(s) * (1.f / DM); float s2 = 0.f;
#pragma unroll
        for (int j = 0; j < 4; ++j) { v[j] = v[j] - mean; s2 += (v[j].x * v[j].x + v[j].y * v[j].y) + (v[j].z * v[j].z + v[j].w * v[j].w); }
        const float rstd = 1.f / sqrtf(wave_sum(s2) * (1.f / DM) + LN_EPS);
        u32x2* o8 = (u32x2*)(xb + (size_t)m * DM) + lane;
#pragma unroll
        for (int j = 0; j < 4; ++j) { const f32x4 y = v[j] * rstd * gv[j] + bv[j]; xw[64 * j] = y; u32x2 w; w.x = pk2(y.x, y.y); w.y = pk2(y.z, y.w); o8[64 * j] = w; }
    }
}
__device__ __forceinline__ void phase_init(const float* x, bf16_t* xb, int gw, int NGW, int lane) {
    for (int m = gw; m < MTOT; m += NGW) {
        const f32x4* xr = (const f32x4*)(x + (size_t)m * DM) + lane; u32x2* o8 = (u32x2*)(xb + (size_t)m * DM) + lane;
#pragma unroll
        for (int j = 0; j < 4; ++j) { const f32x4 y = xr[64 * j]; u32x2 w; w.x = pk2(y.x, y.y); w.y = pk2(y.z, y.w); o8[64 * j] = w; }
    }
}

constexpr int LRU_A_OFF = 0, LRU_A_PITCH = 144, LRU_XF_OFF = 18432, LRU_XF_PITCH = 33, LRU_AGG_OFF = 18432 + 128 * 33 * 4  , LRU_CARRY_OFF = LRU_AGG_OFF + 8 * 32 * 8;
__device__ __forceinline__ void lru_item(const Args& a, int l, int item, LAS unsigned char* lds, const bf16_t* P, bf16_t* Ya, int tid, int wave, int lane) {
    const int bl = item >> 5, hb = (item >> 1) & 15, half = item & 1;
    const int row0 = bl * SEQ, chb = 64 * hb, cho = chb + 32 * half;
    LAS unsigned char* Abuf = lds + LRU_A_OFF; LAS float* xcf = (LAS float*)(lds + LRU_XF_OFF); LAS float* wagg = (LAS float*)(lds + LRU_AGG_OFF); LAS float* carry = (LAS float*)(lds + LRU_CARRY_OFF);
    const int fr = lane & 15, q = lane >> 4;
    bf16x8 bw[4][2];
#pragma unroll
    for (int nt = 0; nt < 4; ++nt) { const float* wsrc = (nt < 2 ? a.in[I_WRG] : a.in[I_WIG]) + ((size_t)(l * 16 + hb) * 64) * 64 + 32 * half + 16 * (nt & 1) + fr;
#pragma unroll
        for (int ks = 0; ks < 2; ++ks) { unsigned w[4];
#pragma unroll
            for (int j = 0; j < 4; ++j) { const int k = 32 * ks + 8 * q + 2 * j; w[j] = pk2(wsrc[(size_t)k * 64], wsrc[(size_t)(k + 1) * 64]); }
            bw[nt][ks] = __builtin_bit_cast(bf16x8, (u32x4){w[0], w[1], w[2], w[3]}); } }
    float brg[2], big[2], sp[2];
#pragma unroll
    for (int cc = 0; cc < 2; ++cc) { const int ch = cho + 16 * cc + fr; brg[cc] = a.in[I_BRG][l * DM + ch]; big[cc] = a.in[I_BIG][l * DM + ch];
        sp[cc] = 8.0f * log1pf(expf(-a.in[I_LAM][l * DM + ch])); }
    const int cp = tid & 31, tg = tid >> 5; const int cch = chb + 2 * cp;
    float cw[4][2], cb[2];
#pragma unroll
    for (int j = 0; j < 4; ++j) { cw[j][0] = a.in[I_CONVW][(l * 4 + j) * DM + cch]; cw[j][1] = a.in[I_CONVW][(l * 4 + j) * DM + cch + 1]; }
    cb[0] = a.in[I_CONVB][l * DM + cch]; cb[1] = a.in[I_CONVB][l * DM + cch + 1];
    if (tid < 64) carry[tid] = 0.f;
    for (int tile = 0; tile < SEQ / 128; ++tile) {
        const int t0 = tile * 128, par = tile & 1;
        {
            float xv[11][2];
#pragma unroll
            for (int j = 0; j < 11; ++j) { const int t = t0 + 8 * tg - 3 + j; unsigned w = 0u; if (t >= 0) w = *(const unsigned*)(P + (size_t)(row0 + t) * INW + C_LX + cch); xv[j][0] = bf_lo(w); xv[j][1] = bf_hi(w); }
#pragma unroll
            for (int i = 0; i < 8; ++i) { float x0 = cb[0], x1 = cb[1];
#pragma unroll
                for (int j = 0; j < 4; ++j) { x0 += cw[j][0] * xv[i + j][0]; x1 += cw[j][1] * xv[i + j][1]; }
                const int tt = 8 * tg + i;
                *(LAS unsigned*)(Abuf + tt * LRU_A_PITCH + 4 * cp) = pk2(x0, x1);
                if ((cp >> 4) == half) { xcf[tt * LRU_XF_PITCH + 2 * (cp & 15)] = x0; xcf[tt * LRU_XF_PITCH + 2 * (cp & 15) + 1] = x1; } }
        }
        LDS_WAIT(); __syncthreads();
        f32x4 acc[4];
#pragma unroll
        for (int nt = 0; nt < 4; ++nt) acc[nt] = (f32x4){0.f, 0.f, 0.f, 0.f};
#pragma unroll
        for (int ks = 0; ks < 2; ++ks) { const bf16x8 af = *(const LAS bf16x8*)(Abuf + (16 * wave + fr) * LRU_A_PITCH + 64 * ks + 16 * q);
#pragma unroll
            for (int nt = 0; nt < 4; ++nt) acc[nt] = __builtin_amdgcn_mfma_f32_16x16x32_bf16(af, bw[nt][ks], acc[nt], 0, 0, 0); }
        bf16_t gt[2][4];
#pragma unroll
        for (int cc = 0; cc < 2; ++cc)
#pragma unroll
            for (int i = 0; i < 4; ++i) gt[cc][i] = P[(size_t)(row0 + t0 + 16 * wave + 4 * q + i) * INW + C_LG + cho + 16 * cc + fr];
        float A_[2][4], H_[2][4], Ae[2], He[2];
#pragma unroll
        for (int cc = 0; cc < 2; ++cc) {
            float av[4], bv[4];
#pragma unroll
            for (int i = 0; i < 4; ++i) { const int tt = 16 * wave + 4 * q + i;
                const float r = sigm(acc[cc][i] + brg[cc]), ig = sigm(acc[cc + 2][i] + big[cc]);
                const float la = -r * sp[cc];
                av[i] = expf(la); const float mult = sqrtf(-expm1f(2.0f * la));
                bv[i] = mult * ig * xcf[tt * LRU_XF_PITCH + 16 * cc + fr]; }
            H_[cc][0] = bv[0]; A_[cc][0] = av[0];
#pragma unroll
            for (int i = 1; i < 4; ++i) { H_[cc][i] = av[i] * H_[cc][i - 1] + bv[i]; A_[cc][i] = av[i] * A_[cc][i - 1]; }
            float Ag = A_[cc][3], Hg = H_[cc][3];
            float t = __shfl_up(Ag, 16), u = __shfl_up(Hg, 16); if (q >= 1) { Hg = Ag * u + Hg; Ag = Ag * t; }
            t = __shfl_up(Ag, 32); u = __shfl_up(Hg, 32); if (q >= 2) { Hg = Ag * u + Hg; Ag = Ag * t; }
            t = __shfl_up(Ag, 16); u = __shfl_up(Hg, 16); Ae[cc] = q ? t : 1.0f; He[cc] = q ? u : 0.0f;
            if (q == 3) { wagg[(wave * 32 + 16 * cc + fr) * 2] = Ag; wagg[(wave * 32 + 16 * cc + fr) * 2 + 1] = Hg; }
        }
        LDS_WAIT(); __syncthreads();
#pragma unroll
        for (int cc = 0; cc < 2; ++cc) { const int c = 16 * cc + fr;
            float hin = carry[par * 32 + c];
            for (int w2 = 0; w2 < wave; ++w2) hin = wagg[(w2 * 32 + c) * 2] * hin + wagg[(w2 * 32 + c) * 2 + 1];
            const float hl = Ae[cc] * hin + He[cc];
#pragma unroll
            for (int i = 0; i < 4; ++i) { const float hv = A_[cc][i] * hl + H_[cc][i];
                if (i == 3 && wave == 7 && q == 3) carry[(par ^ 1) * 32 + c] = hv;
                const float gx = bf2f(gt[cc][i]); const float uu = 0.7978845608028654f * (gx + 0.044715f * gx * gx * gx);
                const float yv = hv * gx * sigm(2.0f * uu);
                Ya[(size_t)(row0 + t0 + 16 * wave + 4 * q + i) * DM + cho + c] = (bf16_t)f2bf(yv); } }
    }
    LDS_WAIT(); __syncthreads();
}

__device__ __forceinline__ void attn_item(const bf16_t* __restrict__ P, bf16_t* __restrict__ Y, int row0, int qcol, int kcol, int vcol, int ycol, int tq,
                                          int a0, int nA, int r4, int nB, float sink2, bool has_sink, LAS unsigned char* vb, int lane) {
    const int r = lane & 31, h = lane >> 5;
    constexpr float CS = 0.125f * LOG2E;
    bf16x8 qf[4];
    { const bf16_t* qp = P + (size_t)(row0 + tq) * INW + qcol + 8 * h;
#pragma unroll
      for (int ks = 0; ks < 4; ++ks) qf[ks] = *(const bf16x8*)(qp + 16 * ks); }
    f32x16 o0, o1;
#pragma unroll
    for (int i = 0; i < 16; ++i) { o0[i] = 0.f; o1[i] = 0.f; }
    float m = -1e30f, lsum = 0.f;
    const int nT = nA + nB;
    bf16x8 kf[4], vr[4];
    const int vrow = lane >> 3, vc = lane & 7;
#define ATT_PARAMS(ti, kt0, kst) do { if ((ti) < nA) { kt0 = a0 + 32 * (ti); kst = 1; } else { kt0 = r4 + 128 * ((ti) - nA); kst = 4; } } while (0)
#define ATT_LOAD(ti) do { int kt0_, kst_; ATT_PARAMS(ti, kt0_, kst_); \
        const bf16_t* kp_ = P + (size_t)(row0 + kt0_ + kst_ * r) * INW + kcol + 8 * h; \
        _Pragma("unroll") for (int ks = 0; ks < 4; ++ks) kf[ks] = *(const bf16x8*)(kp_ + 16 * ks); \
        _Pragma("unroll") for (int i = 0; i < 4; ++i) vr[i] = *(const bf16x8*)(P + (size_t)(row0 + kt0_ + kst_ * (8 * i + vrow)) * INW + vcol + 8 * vc); } while (0)
    ATT_LOAD(0);
    const int vwoff = (vc >> 2) * 2048 + vrow * 64 + (vc & 3) * 16;
    const int g = lane >> 4, idx = lane & 15;
    const int vroff = (4 * h + (idx >> 2)) * 64 + 32 * (g & 1) + 8 * (idx & 3);
    for (int ti = 0; ti < nT; ++ti) {
        int kt0, kst; ATT_PARAMS(ti, kt0, kst);
        const bool mode1 = ti >= nA;
        asm volatile("" ::: "memory");
#pragma unroll
        for (int i = 0; i < 4; ++i) *(LAS bf16x8*)(vb + vwoff + i * 512) = vr[i];
        bf16x8 kc[4];
#pragma unroll
        for (int ks = 0; ks < 4; ++ks) kc[ks] = kf[ks];
        if (ti + 1 < nT) ATT_LOAD(ti + 1);
        f32x16 s;
#pragma unroll
        for (int i = 0; i < 16; ++i) s[i] = 0.f;
#pragma unroll
        for (int ks = 0; ks < 4; ++ks) s = __builtin_amdgcn_mfma_f32_32x32x16_bf16(kc[ks], qf[ks], s, 0, 0, 0);
        float mx = -1e30f;
#pragma unroll
        for (int i = 0; i < 16; ++i) { const int n = (i & 3) + 8 * (i >> 2) + 4 * h; const int dlt = tq - (kt0 + kst * n);
            float lw;
            if (!mode1) lw = (dlt >= 0 && dlt <= 128) ? 0.f : -__builtin_inff();
            else { const int w = (dlt >= 0) ? ((dlt <= 512 ? 1 : 0) + ((dlt & 15) == 0 ? 1 : 0)) : 0; lw = (w == 0) ? -__builtin_inff() : (w == 2 ? 1.0f : 0.f); }
            s[i] = s[i] * CS + lw; mx = fmaxf(mx, s[i]); }
        mx = fmaxf(mx, __shfl_xor(mx, 32));
        const float mn = fmaxf(m, mx); const float alpha = ex2(m - mn); m = mn;
        float rs = 0.f;
#pragma unroll
        for (int i = 0; i < 16; ++i) { s[i] = ex2(s[i] - mn); rs += s[i]; }
        lsum = lsum * alpha + rs;
#pragma unroll
        for (int i = 0; i < 16; ++i) { o0[i] *= alpha; o1[i] *= alpha; }
        bf16x8 pf[2];
#pragma unroll
        for (int sb = 0; sb < 2; ++sb) { u32x4 w; w.x = pk2(s[8 * sb + 0], s[8 * sb + 1]); w.y = pk2(s[8 * sb + 2], s[8 * sb + 3]); w.z = pk2(s[8 * sb + 4], s[8 * sb + 5]); w.w = pk2(s[8 * sb + 6], s[8 * sb + 7]);
            pf[sb] = __builtin_bit_cast(bf16x8, w); }
        LDS_WAIT();
#pragma unroll
        for (int dt = 0; dt < 2; ++dt)
#pragma unroll
            for (int sb = 0; sb < 2; ++sb) {
                const s16x4 v0 = __builtin_bit_cast(s16x4, __builtin_amdgcn_ds_read_tr16_b64_v4i16((LAS s16x4*)(vb + vroff + dt * 2048 + sb * 1024)));
                const s16x4 v1 = __builtin_bit_cast(s16x4, __builtin_amdgcn_ds_read_tr16_b64_v4i16((LAS s16x4*)(vb + vroff + dt * 2048 + sb * 1024 + 512)));
                const bf16x8 vf = (bf16x8){v0[0], v0[1], v0[2], v0[3], v1[0], v1[1], v1[2], v1[3]};
                if (dt == 0) o0 = __builtin_amdgcn_mfma_f32_32x32x16_bf16(vf, pf[sb], o0, 0, 0, 0);
                else o1 = __builtin_amdgcn_mfma_f32_32x32x16_bf16(vf, pf[sb], o1, 0, 0, 0);
            }
        asm volatile("" ::: "memory");
    }
#undef ATT_LOAD
#undef ATT_PARAMS
    lsum += __shfl_xor(lsum, 32);
    float scale;
    if (has_sink) { const float mf = fmaxf(m, sink2); const float al = ex2(m - mf); scale = al * rcpf_(lsum * al + ex2(sink2 - mf)); }
    else scale = rcpf_(lsum);
    bf16_t* yp = Y + (size_t)(row0 + tq) * DM + ycol + 4 * h;
#pragma unroll
    for (int g4 = 0; g4 < 4; ++g4) {
        u32x2 w0; w0.x = pk2(o0[4 * g4] * scale, o0[4 * g4 + 1] * scale); w0.y = pk2(o0[4 * g4 + 2] * scale, o0[4 * g4 + 3] * scale); *(u32x2*)(yp + 8 * g4) = w0;
        u32x2 w1; w1.x = pk2(o1[4 * g4] * scale, o1[4 * g4 + 1] * scale); w1.y = pk2(o1[4 * g4 + 2] * scale, o1[4 * g4 + 3] * scale); *(u32x2*)(yp + 32 + 8 * g4) = w1;
    }
}

__device__ __forceinline__ void phase_mixer(const Args& a, int l, LAS unsigned char* lds, const bf16_t* P, bf16_t* Yb, int tid, int wave, int lane) {
    for (int item = blockIdx.x; item < SEQ_PER_CH * 32; item += gridDim.x) lru_item(a, l, item, lds, P, Yb, tid, wave, lane);
    LAS unsigned char* vb = lds + wave * 4096;
    const int W = blockIdx.x * 8 + wave, NW = gridDim.x * 8;
    for (int it = W; it < SEQ_PER_CH * 16 * 64; it += NW) {
        const int bl = it >> 10, hq = (it >> 6) & 15, blk = it & 63; const int t0 = 32 * blk;
        const int a0 = t0 >= 128 ? t0 - 128 : 0, nA = (t0 + 32 - a0) >> 5;
        attn_item(P, Yb + (size_t)MC * DM, bl * SEQ, C_QB + 64 * hq, C_KB + 64 * (hq >> 2), C_VB + 64 * (hq >> 2), 64 * hq, t0 + (lane & 31), a0, nA, 0, 0,
                  a.in[I_SINK][l * 16 + hq] * LOG2E, true, vb, lane);
    }
    for (int wk = W; wk < SEQ_PER_CH * 16 * 16; wk += NW) {
        const int bl = wk >> 8, hq = (wk >> 4) & 15, pg = wk & 15, r4 = pg & 3, aa = pg >> 2;
#pragma unroll 1
        for (int k = 0; k < 4; ++k) {
            const int blk = (k == 0) ? aa : (k == 1) ? 7 - aa : (k == 2) ? 8 + aa : 15 - aa; const int T0 = 128 * blk;
            const int a0 = T0 >= 128 ? T0 - 128 : 0, nA = (T0 + 128 - a0) >> 5, nB = blk + 1;
            attn_item(P, Yb + (size_t)2 * MC * DM, bl * SEQ, C_QC + 64 * hq, C_KC + 64 * hq, C_VC + 64 * hq, 64 * hq, T0 + r4 + 4 * (lane & 31), a0, nA, r4, nB, 0.f, false, vb, lane);
        }
    }
}


#define XB_TMO      128
#define XB_XCNT(j)  (256  + 64 * (j))
#define XB_XSUB(j)  (1280 + 64 * (j))
#define XB_XGEN(j)  (2304 + 64 * (j))
#define XB_TOP      3328
#define XB_TOPGEN   3392
#define XCD_BAR_WORDS 3456
#define XB_SPIN_CAP (1u << 18)
__device__ __forceinline__ unsigned xb_ld(unsigned* p)              { return __hip_atomic_load(p, __ATOMIC_RELAXED, __HIP_MEMORY_SCOPE_AGENT); }
__device__ __forceinline__ unsigned xb_add(unsigned* p, unsigned v) { return __hip_atomic_fetch_add(p, v, __ATOMIC_RELAXED, __HIP_MEMORY_SCOPE_AGENT); }
__device__ __forceinline__ unsigned xb_xcc_id() { return (unsigned)__builtin_amdgcn_s_getreg((3 << 11) | 20) & 0xFu; }
#define XB_SPIN(cond, bar) do { unsigned _sp = 0; while (cond) { __builtin_amdgcn_s_sleep(1); \
    if ((++_sp & 255u) == 0u) { if (xb_ld(&(bar)[XB_TMO])) break; if (_sp > XB_SPIN_CAP) { atomicAdd(&(bar)[XB_TMO], 1u); break; } } } } while (0)
struct XcdBarrier { unsigned* bar; unsigned x; volatile LAS unsigned* st; };
__device__ __forceinline__ XcdBarrier xcd_barrier_post(unsigned* bar, volatile LAS unsigned* st) {
    XcdBarrier b; b.bar = bar; b.x = xb_xcc_id(); b.st = st;
    if (threadIdx.x == 0) (void)xb_add(&bar[XB_XCNT(b.x)], 1u);
    return b;
}
__device__ __forceinline__ void xcd_barrier_complete(unsigned* bar, unsigned x, unsigned& nloc, unsigned& nx) {
    const unsigned G = gridDim.x * gridDim.y * gridDim.z;
    unsigned sum, cnt, mine, sp = 0u;
    for (;;) {
        sum = 0u; cnt = 0u; mine = 0u;
#pragma unroll
        for (unsigned j = 0; j < 16; ++j) { const unsigned c = xb_ld(&bar[XB_XCNT(j)]); sum += c; cnt += (c > 0u) ? 1u : 0u; mine = (j == x) ? c : mine; }
        if (sum == G) break;
        __builtin_amdgcn_s_sleep(1);
        if ((++sp & 255u) == 0u) { if (xb_ld(&bar[XB_TMO])) break; if (sp > XB_SPIN_CAP) { atomicAdd(&bar[XB_TMO], 1u); break; } }
    }
    nloc = mine > 0u ? mine : 1u; nx = cnt > 0u ? cnt : 1u;
}
__device__ __forceinline__ void xcd_barrier(const XcdBarrier& b) {
    asm volatile("s_waitcnt vmcnt(0)" ::: "memory");
    __syncthreads();
    if (threadIdx.x == 0) {
        unsigned* bar = b.bar;
        __builtin_amdgcn_s_waitcnt(0);
        unsigned nloc = b.st[0], nx = b.st[1];
        if (nloc == 0u) { xcd_barrier_complete(bar, b.x, nloc, nx); b.st[0] = nloc; b.st[1] = nx; }
        const unsigned old = xb_add(&bar[XB_XSUB(b.x)], 1u);
        const unsigned gen = old / nloc;
        if (old + 1u == (gen + 1u) * nloc) {
            __builtin_amdgcn_fence(__ATOMIC_RELEASE, "agent");
            asm volatile("s_waitcnt vmcnt(0)" ::: "memory");
            const unsigned og = xb_add(&bar[XB_TOP], 1u);
            const unsigned tg = og / nx;
            if (og + 1u == (tg + 1u) * nx) xb_add(&bar[XB_TOPGEN], 1u);
            else XB_SPIN(xb_ld(&bar[XB_TOPGEN]) == tg, bar);
            __builtin_amdgcn_fence(__ATOMIC_ACQUIRE, "agent");
            xb_add(&bar[XB_XGEN(b.x)], 1u);
            asm volatile("s_waitcnt vmcnt(0)" ::: "memory");
        } else {
            XB_SPIN(xb_ld(&bar[XB_XGEN(b.x)]) == gen, bar);
            __builtin_amdgcn_fence(__ATOMIC_ACQUIRE, "agent");
            asm volatile("s_waitcnt vmcnt(0)" ::: "memory");
        }
    }
    __syncthreads();
}

__global__ void __launch_bounds__(512, 2) mega_fwd(Args a) {
    extern __shared__ __attribute__((aligned(16))) unsigned char lds_raw[];
    LAS unsigned char* lds = (LAS unsigned char*)lds_raw;
    const int tid = threadIdx.x, lane = tid & 63, wave = __builtin_amdgcn_readfirstlane(tid >> 6);
    const int G = gridDim.x, gw = blockIdx.x * 8 + wave, NGW = G * 8;
    unsigned char* ws = a.ws;
    bf16_t* XB = (bf16_t*)(ws + WS_XB); bf16_t* PROJ = (bf16_t*)(ws + WS_PROJ); bf16_t* YB = (bf16_t*)(ws + WS_Y); bf16_t* MRG = (bf16_t*)(ws + WS_MRG); bf16_t* HB = (bf16_t*)(ws + WS_H);
    cg::grid_group grid = cg::this_grid();
    volatile LAS unsigned* MISC = (volatile LAS unsigned*)(lds + 131072);
    if (tid < 64) MISC[tid] = 0u;
    __syncthreads();
    unsigned* barw = (unsigned*)(ws + WS_CTL);
    XcdBarrier bar; bar.bar = barw; bar.x = 0; bar.st = MISC + 8;
    const bool multi_phase = (a.ph_hi - a.ph_lo) > 1;
    if (multi_phase) {
        for (int i = blockIdx.x * 512 + tid; i < XCD_BAR_WORDS; i += G * 512) barw[i] = 0u;
        grid.sync();
        bar = xcd_barrier_post(barw, MISC + 8);
    }
    const int tid0 = tid, lane0 = lane;
#pragma unroll 1
    for (int ph = a.ph_lo; ph < a.ph_hi; ++ph) {
        if (ph > a.ph_lo) { if (PROBE_ST == 11) grid.sync(); else xcd_barrier(bar); if (PROBE_ST == 9) { for (int r9 = 0; r9 < PROBE_REP; ++r9) xcd_barrier(bar); } }
        int tid = tid0, lane = lane0; asm volatile("" : "+v"(tid), "+v"(lane));
        if (ph == 0) { phase_init(a.in[I_X], XB, gw, NGW, lane); continue; }
        const int qq = ph - 1, l = qq / 17, rr = qq % 17;
        if (rr == 0) { for (int r8 = 0; r8 <= (PROBE_ST == 8 ? PROBE_REP : 0); ++r8) phase_weights(a, l, ws, lds, gw, NGW, wave, lane); if (PROBE_ST == 10) phase_weights(a, (l + 2) & 3, ws + WS_END, lds, gw, NGW, wave, lane); continue; }
        const int c = (rr - 1) >> 3, st = (rr - 1) & 7;
        const size_t crow = (size_t)c * MC;
        float* xres = a.out + crow * DM; bf16_t* xb = XB + crow * DM;
        const int nrep = (st == PROBE_ST) ? PROBE_REP : 0;
#pragma unroll 1
        for (int rep = 0; rep <= nrep; ++rep) {
        float* xdst = (rep < nrep) ? (float*)(ws + WS_END) : xres;
        if (rep) __syncthreads();
        int tid = tid0, lane = lane0; asm volatile("" : "+v"(tid), "+v"(lane));
        if (st == 0 && (PH_MASK & 1)) {
            pg8::StaticOrder S; S.init(MC, INW, G, (int)blockIdx.x); pg8::EpiProj E{PROJ, INW};
            pg8::gemm_phase(lds, xb, DM, (const bf16_t*)(ws + WS_WIN), DM, S, E, tid);
        } else if (st == 1 && (PH_MASK & 2)) {
            phase_mixer(a, l, lds, PROJ, YB, tid, wave, lane);
        } else if (st == 2 && (PH_MASK & 4)) {
            pg8::BranchOrder S; S.init(G, (int)blockIdx.x); pg8::EpiBranch E{PROJ, MRG};
            pg8::gemm_phase(lds, YB, DM, (const bf16_t*)(ws + WS_WBR), DM, S, E, tid);
        } else if (st == 3 && (PH_MASK & 8)) {
            pg8::StaticOrder S; S.init(MC, DM, G, (int)blockIdx.x); pg8::EpiResid E{(l == 0 ? a.in[I_X] : a.out) + crow * DM, xdst};
            pg8::gemm_phase(lds, MRG, DM, (const bf16_t*)(ws + WS_WOUT), DM, S, E, tid);
        } else if (st == 4 && (PH_MASK & 16)) {
            phase_ln(xres, xdst, xb, a.in[I_LN1G] + l * DM, a.in[I_LN1B] + l * DM, MC, gw, NGW, lane);
        } else if (st == 5 && (PH_MASK & 32)) {
            pg8::StaticOrder S; S.init(MC, FF2, G, (int)blockIdx.x); pg8::EpiSwiGLU E{HB};
            pg8::gemm_phase(lds, xb, DM, (const bf16_t*)(ws + WS_WF1), DM, S, E, tid);
        } else if (st == 6 && (PH_MASK & 64)) {
            pg8::StaticOrder S; S.init(MC, DM, G, (int)blockIdx.x); pg8::EpiResid E{xres, xdst};
            pg8::gemm_phase(lds, HB, FFH, (const bf16_t*)(ws + WS_WF2), FFH, S, E, tid);
        } else if (PH_MASK & 128) {
            phase_ln(xres, xdst, xb, a.in[I_LN2G] + l * DM, a.in[I_LN2B] + l * DM, MC, gw, NGW, lane);
        }
        }
    }
}

extern "C" void kernel_launch(void* const* d_in, const int* in_sizes, int n_in, void* d_out, int out_size, void* d_ws, size_t ws_size, hipStream_t stream) {
    static int grid = 0;
    if (grid == 0) {
        if (n_in != 18 || out_size != MTOT * DM || ws_size < WS_NEED) { fprintf(stderr, "kernel_launch: unexpected shapes (n_in %d out %d ws %zu)\n", n_in, out_size, ws_size); grid = -1; return; }
        int dev = 0, cus = 0, per_cu = 0;
        hipGetDevice(&dev); hipDeviceGetAttribute(&cus, hipDeviceAttributeMultiprocessorCount, dev);
        if (hipFuncSetAttribute((const void*)mega_fwd, hipFuncAttributeMaxDynamicSharedMemorySize, LDS_BYTES) != hipSuccess) { fprintf(stderr, "kernel_launch: hipFuncSetAttribute failed\n"); grid = -1; return; }
        if (hipOccupancyMaxActiveBlocksPerMultiprocessor(&per_cu, (const void*)mega_fwd, 512, LDS_BYTES) != hipSuccess || per_cu < 1) { fprintf(stderr, "kernel_launch: occupancy query says %d\n", per_cu); per_cu = 1; }
        (void)hipGetLastError();
        grid = cus * per_cu;
    }
    if (grid < 0) return;
    Args a{};
    for (int i = 0; i < 18; ++i) a.in[i] = (const float*)d_in[i];
    a.out = (float*)d_out; a.ws = (unsigned char*)d_ws;
#if MK_MULTI
    for (int ph = 0; ph < NPH; ++ph) { a.ph_lo = ph; a.ph_hi = ph + 1; hipLaunchKernelGGL(mega_fwd, dim3(grid), dim3(512), LDS_BYTES, stream, a); }
#else
    a.ph_lo = 0; a.ph_hi = NPH;
    void* args[] = {&a};
    hipError_t e = hipLaunchCooperativeKernel((const void*)mega_fwd, dim3(grid), dim3(512), args, LDS_BYTES, stream);
    if (e != hipSuccess) fprintf(stderr, "cooperative launch failed: %s (grid %d)\n", hipGetErrorString(e), grid);
#endif
}
```

```cpp
#include <hip/hip_runtime.h>
#include <hip/hip_cooperative_groups.h>
#include <cstdio>
namespace cg = cooperative_groups;

#ifndef MK_MULTI
#define MK_MULTI 0
#endif

#ifndef PROBE_ST
#define PROBE_ST -1
#define PROBE_REP 0
#endif
#ifndef PH_MASK
#define PH_MASK 255
#endif
#define LAS __attribute__((address_space(3)))
typedef unsigned short bf16_t;
typedef short bf16x8 __attribute__((ext_vector_type(8)));
typedef short s16x4 __attribute__((ext_vector_type(4)));
typedef float f32x4 __attribute__((ext_vector_type(4)));
typedef float f32x16 __attribute__((ext_vector_type(16)));
typedef unsigned u32x4 __attribute__((ext_vector_type(4)));
typedef unsigned u32x2 __attribute__((ext_vector_type(2)));

constexpr int DM = 1024, SEQ = 2048, BATCH = 16, DEPTH = 4, INW = 9728, FFH = 2816, FF2 = 5632;
constexpr int NCH = 2, MC = 16384, SEQ_PER_CH = 8, MTOT = BATCH * SEQ;
constexpr int C_LX = 0, C_LG = 1024, C_QB = 2048, C_KB = 3072, C_VB = 3328, C_QC = 3584, C_KC = 4608, C_VC = 5632, C_GATE = 6656;
constexpr float LN_EPS = 1e-5f;
constexpr float ALPHA = 1.681792830507429f;
constexpr float LOG2E = 1.4426950408889634f;
constexpr size_t MiB = 1u << 20;
constexpr size_t WS_WIN = 0, WS_WBR = 19 * MiB, WS_WOUT = 25 * MiB, WS_WF1 = 27 * MiB, WS_WF2 = 38 * MiB, WS_XB = 44 * MiB, WS_PROJ = 108 * MiB,
                 WS_Y = 412 * MiB, WS_MRG = 508 * MiB, WS_END = 540 * MiB, WS_H = WS_PROJ, WS_CTL = 604 * MiB  , WS_NEED = 605 * MiB;
constexpr int LDS_BYTES = 147456;
constexpr int NPH = 1 + DEPTH * 17;

__device__ __forceinline__ unsigned f2bf(float f) { unsigned u = __builtin_bit_cast(unsigned, f); return (u + 0x7fffu + ((u >> 16) & 1u)) >> 16; }
__device__ __forceinline__ unsigned pk2(float lo, float hi) { unsigned r; asm volatile("v_cvt_pk_bf16_f32 %0, %1, %2" : "=v"(r) : "v"(lo), "v"(hi)); return r; }
__device__ __forceinline__ float bf_lo(unsigned w) { return __builtin_bit_cast(float, w << 16); }
__device__ __forceinline__ float bf_hi(unsigned w) { return __builtin_bit_cast(float, w & 0xffff0000u); }
__device__ __forceinline__ float bf2f(bf16_t b) { return __builtin_bit_cast(float, ((unsigned)b) << 16); }
__device__ __forceinline__ float ex2(float x) { return __builtin_amdgcn_exp2f(x); }
__device__ __forceinline__ float rcpf_(float x) { return __builtin_amdgcn_rcpf(x); }
__device__ __forceinline__ float sigm(float x) { return rcpf_(1.0f + ex2(-x * LOG2E)); }
__device__ __forceinline__ float wave_sum(float v) {
#pragma unroll
    for (int o = 1; o < 64; o <<= 1) v += __shfl_xor(v, o);
    return v;
}
#define LDS_WAIT() asm volatile("s_waitcnt lgkmcnt(0)" ::: "memory")

namespace pg8 {
constexpr int BM = 256, BK = 64, HALF = 128, HTB = HALF * BK * 2, STAGE_BYTES = 8 * HTB, NXCD = 8, WGM = 8;
__host__ __device__ __forceinline__ int lds_byte(int r, int c) { const int st = (r >> 4) * 2 + (c >> 5), rr = r & 15, cc = c & 31, ob = rr * 64 + cc * 2; return st * 1024 + (ob ^ (((ob >> 9) & 1) << 5)); }
__host__ __device__ __forceinline__ void stage_rc(int b, int& R, int& C) { const int st = b / 1024, sb = b % 1024, swz = sb ^ (((sb >> 9) & 1) << 5); R = (st >> 1) * 16 + swz / 64; C = (st & 1) * 32 + (swz % 64) / 2; }
__host__ __device__ __forceinline__ int perm32(int rho) { const int n = rho >> 4, i = rho & 15; return 8 * (i >> 2) + 4 * n + (i & 3); }
struct Unit { int pm, pn; };
struct StaticOrder {
    int nM, nN, nwg, G, c;
    __device__ void init(int M, int N, int G_, int c_) { nM = M / BM; nN = N / BM; nwg = nM * nN; G = G_; c = c_; }
    __device__ bool next(int i, Unit& u) const {
        const long L = (long)i * G + c; if (L >= nwg) return false;
        int wgid = (int)L; { const int q = nwg / NXCD, r = nwg % NXCD, xcd = wgid % NXCD, off = wgid / NXCD; wgid = (xcd < r ? xcd * (q + 1) : r * (q + 1) + (xcd - r) * q) + off; }
        const int nig = WGM * nN, gid = wgid / nig, fm = gid * WGM, gsz = (nM - fm) < WGM ? (nM - fm) : WGM;
        u.pm = fm + ((wgid % nig) % gsz); u.pn = (wgid % nig) / gsz; return true;
    }
};
struct BranchOrder {
    StaticOrder so;
    __device__ void init(int G_, int c_) { so.init(MC, DM, G_, c_); }
    __device__ bool next(int i, Unit& u) const { const int t = i / 3, n = i - 3 * t; Unit b; if (!so.next(t, b)) return false; u.pm = n * (MC / BM) + b.pm; u.pn = n * (DM / BM) + b.pn; return true; }
};

typedef f32x4 Acc[2][2][4][2];

struct EpiProj {
    static constexpr bool PERM = true;
    bf16_t* O; int ldc;
    __device__ __forceinline__ bool operator()(Acc& acc, const Unit& u, int wr, int wc, int fr, int fq) const {
        const int row0 = u.pm * BM + wr * 64 + fr, col0 = u.pn * BM + wc * 32 + 8 * fq;
#pragma unroll
        for (int ai = 0; ai < 2; ++ai)
#pragma unroll
            for (int m = 0; m < 4; ++m) { bf16_t* rowp = O + (size_t)(row0 + ai * HALF + m * 16) * ldc + col0;
#pragma unroll
                for (int bj = 0; bj < 2; ++bj) { const f32x4 v0 = acc[ai][bj][m][0], v1 = acc[ai][bj][m][1];
                    u32x4 w; w.x = pk2(v0[0], v0[1]); w.y = pk2(v0[2], v0[3]); w.z = pk2(v1[0], v1[1]); w.w = pk2(v1[2], v1[3]);
                    *(u32x4*)(rowp + bj * HALF) = w; } }
        return false;
    }
};
struct EpiBranch {
    static constexpr bool PERM = true;
    const bf16_t* P; bf16_t* O;
    __device__ __forceinline__ bool operator()(Acc& acc, const Unit& u, int wr, int wc, int fr, int fq) const {
        const int n = u.pn >> 2, pn = u.pn & 3, pm = u.pm & 63;
        const int row0 = pm * BM + wr * 64 + fr, col0 = pn * BM + wc * 32 + 8 * fq;
#pragma unroll
        for (int ai = 0; ai < 2; ++ai)
#pragma unroll
            for (int m = 0; m < 4; ++m) { const int row = row0 + ai * HALF + m * 16;
#pragma unroll
                for (int bj = 0; bj < 2; ++bj) {
                    const bf16_t* gp = P + (size_t)row * INW + C_GATE + n * DM + col0 + bj * HALF;
                    const u32x4 ga = *(const u32x4*)gp; u32x4 gb = ga; if (n < 2) gb = *(const u32x4*)(gp + DM);
                    float fa[8], fb[8];
                    fa[0] = bf_lo(ga.x); fa[1] = bf_hi(ga.x); fa[2] = bf_lo(ga.y); fa[3] = bf_hi(ga.y); fa[4] = bf_lo(ga.z); fa[5] = bf_hi(ga.z); fa[6] = bf_lo(ga.w); fa[7] = bf_hi(ga.w);
                    fb[0] = bf_lo(gb.x); fb[1] = bf_hi(gb.x); fb[2] = bf_lo(gb.y); fb[3] = bf_hi(gb.y); fb[4] = bf_lo(gb.z); fb[5] = bf_hi(gb.z); fb[6] = bf_lo(gb.w); fb[7] = bf_hi(gb.w);
                    float v[8];
#pragma unroll
                    for (int j = 0; j < 8; ++j) { const float da = 1.0f + ex2(-fa[j] * LOG2E); const float nb = (n < 2) ? (1.0f + ex2(-fb[j] * LOG2E)) : 1.0f;
                        const float f = nb * rcpf_(da); v[j] = acc[ai][bj][m][j >> 2][j & 3] * f; }
                    acc[ai][bj][m][0] = (f32x4){v[0], v[1], v[2], v[3]}; acc[ai][bj][m][1] = (f32x4){v[4], v[5], v[6], v[7]};
                    if (n == 2) { u32x4 w; w.x = pk2(v[0], v[1]); w.y = pk2(v[2], v[3]); w.z = pk2(v[4], v[5]); w.w = pk2(v[6], v[7]);
                        *(u32x4*)(O + (size_t)row * DM + col0 + bj * HALF) = w; }
                } }
        return n < 2;
    }
};
struct EpiResid {
    static constexpr bool PERM = false;
    const float* src; float* dst;
    __device__ __forceinline__ bool operator()(Acc& acc, const Unit& u, int wr, int wc, int fr, int fq) const {
        const int row0 = u.pm * BM + wr * 64 + fr, col0 = u.pn * BM + wc * 32 + 4 * fq;
#pragma unroll
        for (int ai = 0; ai < 2; ++ai)
#pragma unroll
            for (int m = 0; m < 4; ++m) { const size_t off = (size_t)(row0 + ai * HALF + m * 16) * DM + col0;
#pragma unroll
                for (int bj = 0; bj < 2; ++bj)
#pragma unroll
                    for (int n = 0; n < 2; ++n) { const f32x4 bs = *(const f32x4*)(src + off + bj * HALF + n * 16); *(f32x4*)(dst + off + bj * HALF + n * 16) = bs * ALPHA + acc[ai][bj][m][n]; } }
        return false;
    }
};
struct EpiSwiGLU {
    static constexpr bool PERM = true;
    bf16_t* H;
    __device__ __forceinline__ bool operator()(Acc& acc, const Unit& u, int wr, int wc, int fr, int fq) const {
        const int row0 = u.pm * BM + wr * 64 + fr, col0 = u.pn * 128 + wc * 16 + 4 * fq;
#pragma unroll
        for (int ai = 0; ai < 2; ++ai)
#pragma unroll
            for (int m = 0; m < 4; ++m) { bf16_t* rowp = H + (size_t)(row0 + ai * HALF + m * 16) * FFH + col0;
#pragma unroll
                for (int bj = 0; bj < 2; ++bj) { const f32x4 a = acc[ai][bj][m][0], b = acc[ai][bj][m][1]; float v[4];
#pragma unroll
                    for (int j = 0; j < 4; ++j) v[j] = a[j] * sigm(a[j]) * b[j];
                    u32x2 w; w.x = pk2(v[0], v[1]); w.y = pk2(v[2], v[3]); *(u32x2*)(rowp + bj * 64) = w; } }
        return false;
    }
};

template <class Epi, class Sched>
__device__ __forceinline__ void gemm_phase(LAS unsigned char* lds, const bf16_t* Ab, int lda, const bf16_t* Btb, int K, const Sched& S, const Epi& E, const int tid) {
    const int wid = __builtin_amdgcn_readfirstlane(tid >> 6), lane = tid & 63, wr = wid >> 2, wc = wid & 3, fr = lane & 15, fq = lane >> 4;
    const int nt = K / BK;
    unsigned voffA[2], voffB[2];
#pragma unroll
    for (int i = 0; i < 2; ++i) { int R, C; stage_rc(tid * 16 + i * 8192, R, C); const int Rb = Epi::PERM ? ((R & ~31) + perm32(R & 31)) : R;
        voffA[i] = (unsigned)(R * lda + C) * 2u; voffB[i] = (unsigned)(Rb * K + C) * 2u; }
    const size_t kstep = (size_t)(BK * 2);
    const size_t hstepA = (size_t)HALF * lda * 2, tstepA = 2 * hstepA, hstepB = (size_t)HALF * K * 2, tstepB = 2 * hstepB;
    const unsigned ldsw = (unsigned)wid * 1024u;
    const int aoff = lds_byte(wr * 64 + fr, fq * 8), boff = lds_byte(wc * 32 + fr, fq * 8);
#define PG8_SA(b, h) (((b) * 2 + (h)) * HTB)
#define PG8_SB(b, h) ((4 + (b) * 2 + (h)) * HTB)
#define PG8_STAGE(bufoff, gbase, voff) do { _Pragma("unroll") for (int _i = 0; _i < 2; ++_i) \
        __builtin_amdgcn_global_load_lds((const unsigned*)((const char*)(gbase) + (voff)[_i]), (LAS unsigned*)(lds + (bufoff) + ldsw + _i * 8192), 16, 0, 0); } while (0)
#define PG8_LDA(dst, b, h) do { _Pragma("unroll") for (int m = 0; m < 4; ++m) _Pragma("unroll") for (int k = 0; k < 2; ++k) dst[m][k] = *(const LAS bf16x8*)(lds + PG8_SA(b, h) + aoff + m * 2048 + k * 1024); } while (0)
#define PG8_LDB(dst, b, h) do { _Pragma("unroll") for (int n = 0; n < 2; ++n) _Pragma("unroll") for (int k = 0; k < 2; ++k) dst[n][k] = *(const LAS bf16x8*)(lds + PG8_SB(b, h) + boff + n * 2048 + k * 1024); } while (0)
#define PG8_MMA(ai, bj, At, Bt) do { __builtin_amdgcn_s_setprio(1); _Pragma("unroll") for (int m = 0; m < 4; ++m) _Pragma("unroll") for (int n = 0; n < 2; ++n) _Pragma("unroll") for (int k = 0; k < 2; ++k) \
        acc[ai][bj][m][n] = __builtin_amdgcn_mfma_f32_16x16x32_bf16(Bt[n][k], At[m][k], acc[ai][bj][m][n], 0, 0, 0); __builtin_amdgcn_s_setprio(0); } while (0)
#define PG8_WAIT_V(n) asm volatile("s_waitcnt vmcnt(" #n ")" ::: "memory")
#define PG8_WAIT_L(n) asm volatile("s_waitcnt lgkmcnt(" #n ")" ::: "memory")
#define PG8_BAR __builtin_amdgcn_s_barrier()
#define PG8_SCHED __builtin_amdgcn_sched_barrier(0)
    Unit cur, nxt; int ui = 0;
    if (!S.next(0, cur)) return;
    Acc acc;
#pragma unroll
    for (int a = 0; a < 2; ++a)
#pragma unroll
        for (int b = 0; b < 2; ++b)
#pragma unroll
            for (int m = 0; m < 4; ++m)
#pragma unroll
                for (int n = 0; n < 2; ++n) acc[a][b][m][n] = (f32x4){0.f, 0.f, 0.f, 0.f};
    bf16x8 At[4][2], B0[2][2], B1[2][2];
    const char* cA = (const char*)Ab + (size_t)cur.pm * tstepA; const char* cB = (const char*)Btb + (size_t)cur.pn * tstepB;
    PG8_STAGE(PG8_SB(0, 0), cB, voffB); PG8_STAGE(PG8_SB(0, 1), cB + hstepB, voffB); PG8_STAGE(PG8_SA(0, 0), cA, voffA); PG8_STAGE(PG8_SA(0, 1), cA + hstepA, voffA);
    if (wr == 1) PG8_BAR;
    PG8_WAIT_V(2); PG8_BAR;
    PG8_STAGE(PG8_SB(1, 0), cB + kstep, voffB); PG8_STAGE(PG8_SA(1, 0), cA + kstep, voffA); PG8_STAGE(PG8_SB(1, 1), cB + hstepB + kstep, voffB);
    PG8_WAIT_V(6); PG8_BAR;
    for (;;) {
        const bool has_next = S.next(ui + 1, nxt);
        const char* nA = has_next ? (const char*)Ab + (size_t)nxt.pm * tstepA : cA; const char* nB = has_next ? (const char*)Btb + (size_t)nxt.pn * tstepB : cB;
        for (int t = 0; t < nt; t += 2) {
            const bool last = (t == nt - 2);
            const char* a1 = cA + (size_t)(t + 1) * kstep;
            const char* a2 = last ? nA : cA + (size_t)(t + 2) * kstep; const char* b2 = last ? nB : cB + (size_t)(t + 2) * kstep;
            const char* a3 = a2 + kstep; const char* b3 = b2 + kstep;
            PG8_LDB(B0, 0, 0); PG8_LDB(B1, 0, 1); PG8_SCHED; PG8_LDA(At, 0, 0); PG8_STAGE(PG8_SA(1, 1), a1 + hstepA, voffA);
            PG8_WAIT_V(8); PG8_WAIT_L(0); PG8_BAR; PG8_MMA(0, 0, At, B0); PG8_MMA(0, 1, At, B1); PG8_BAR; PG8_SCHED;
            PG8_LDA(At, 0, 1); PG8_STAGE(PG8_SB(0, 0), b2, voffB); PG8_STAGE(PG8_SB(0, 1), b2 + hstepB, voffB); PG8_STAGE(PG8_SA(0, 0), a2, voffA);
            PG8_WAIT_V(8); PG8_WAIT_L(0); PG8_BAR; PG8_MMA(1, 0, At, B0); PG8_MMA(1, 1, At, B1); PG8_BAR; PG8_SCHED;
            PG8_LDB(B0, 1, 0); PG8_LDB(B1, 1, 1); PG8_SCHED; PG8_LDA(At, 1, 0); PG8_STAGE(PG8_SA(0, 1), a2 + hstepA, voffA);
            PG8_WAIT_V(8); PG8_WAIT_L(0); PG8_BAR; PG8_MMA(0, 0, At, B0); PG8_MMA(0, 1, At, B1); PG8_BAR; PG8_SCHED;
            PG8_LDA(At, 1, 1); PG8_STAGE(PG8_SB(1, 0), b3, voffB); PG8_STAGE(PG8_SB(1, 1), b3 + hstepB, voffB); PG8_STAGE(PG8_SA(1, 0), a3, voffA);
            PG8_WAIT_V(8); PG8_WAIT_L(0); PG8_BAR; PG8_MMA(1, 0, At, B0); PG8_MMA(1, 1, At, B1); PG8_BAR; PG8_SCHED;
        }
        if (wr == 0) PG8_BAR;
        const bool keep = E(acc, cur, wr, wc, fr, fq);
        if (!has_next) break;
        if (!keep) {
#pragma unroll
            for (int a = 0; a < 2; ++a)
#pragma unroll
                for (int b = 0; b < 2; ++b)
#pragma unroll
                    for (int m = 0; m < 4; ++m)
#pragma unroll
                        for (int n = 0; n < 2; ++n) acc[a][b][m][n] = (f32x4){0.f, 0.f, 0.f, 0.f};
        }
        cur = nxt; cA = nA; cB = nB; ++ui;
        if (wr == 1) PG8_BAR;
    }
    PG8_WAIT_V(0);
    PG8_BAR;
#undef PG8_SA
#undef PG8_SB
#undef PG8_STAGE
#undef PG8_LDA
#undef PG8_LDB
#undef PG8_MMA
#undef PG8_WAIT_V
#undef PG8_WAIT_L
#undef PG8_BAR
#undef PG8_SCHED
}
}

struct Args { const float* in[18]; float* out; unsigned char* ws; int ph_lo, ph_hi; };
enum { I_X = 0, I_WIN, I_CONVW, I_CONVB, I_WRG, I_BRG, I_WIG, I_BIG, I_LAM, I_SINK, I_WBR, I_WOUT, I_LN1G, I_LN1B, I_WF1, I_WF2, I_LN2G, I_LN2B };

template <int MODE>
__device__ __forceinline__ void transpose_item(const float* W, int K, int N, bf16_t* WT, int row_off, LAS float* scr, int item, int lane) {
    const int nblk = N / 32, kb = item / nblk, nb = item % nblk, k0 = 64 * kb, n0 = 32 * nb;
#pragma unroll 8
    for (int i = 0; i < 32; ++i) { const int kk = 2 * i + (lane >> 5); scr[kk * 33 + (lane & 31)] = W[(size_t)(k0 + kk) * N + n0 + (lane & 31)]; }
    LDS_WAIT();
    const int c = lane & 7;
#pragma unroll
    for (int j = 0; j < 4; ++j) { const int n = (lane >> 3) + 8 * j; const LAS float* s = scr + (8 * c) * 33 + n;
        u32x4 o; o.x = pk2(s[0 * 33], s[1 * 33]); o.y = pk2(s[2 * 33], s[3 * 33]); o.z = pk2(s[4 * 33], s[5 * 33]); o.w = pk2(s[6 * 33], s[7 * 33]);
        int row = n0 + n;
        if (MODE == 1) { const int sgl = row >= FFH ? 1 : 0; const int jj = row - sgl * FFH; row = 8 * (jj >> 2) + 4 * sgl + (jj & 3); }
        *(u32x4*)(WT + (size_t)(row_off + row) * K + k0 + 8 * c) = o; }
    LDS_WAIT();
}
__device__ __forceinline__ void phase_weights(const Args& a, int l, unsigned char* ws, LAS unsigned char* lds, int gw, int NGW, int wave, int lane) {
    LAS float* scr = (LAS float*)(lds + wave * 16384);
    constexpr int I_IN = 16 * (INW / 32), I_BR1 = 16 * 32, I_OUT = 16 * 32, I_F1 = 16 * (FF2 / 32), I_F2 = (FFH / 64) * 32;
    constexpr int NIT = I_IN + 3 * I_BR1 + I_OUT + I_F1 + I_F2;
    for (int it = gw; it < NIT; it += NGW) {
        int r = it;
        if (r < I_IN) { transpose_item<0>(a.in[I_WIN] + (size_t)l * DM * INW, DM, INW, (bf16_t*)(ws + WS_WIN), 0, scr, r, lane); continue; } r -= I_IN;
        if (r < 3 * I_BR1) { const int n = r / I_BR1; transpose_item<0>(a.in[I_WBR] + ((size_t)l * 3 + n) * DM * DM, DM, DM, (bf16_t*)(ws + WS_WBR), n * DM, scr, r - n * I_BR1, lane); continue; } r -= 3 * I_BR1;
        if (r < I_OUT) { transpose_item<0>(a.in[I_WOUT] + (size_t)l * DM * DM, DM, DM, (bf16_t*)(ws + WS_WOUT), 0, scr, r, lane); continue; } r -= I_OUT;
        if (r < I_F1) { transpose_item<1>(a.in[I_WF1] + (size_t)l * DM * FF2, DM, FF2, (bf16_t*)(ws + WS_WF1), 0, scr, r, lane); continue; } r -= I_F1;
        transpose_item<0>(a.in[I_WF2] + (size_t)l * FFH * DM, FFH, DM, (bf16_t*)(ws + WS_WF2), 0, scr, r, lane);
    }
}

__device__ __forceinline__ void phase_ln(const float* zx, float* xo, bf16_t* xb, const float* g, const float* b, int nrows, int gw, int NGW, int lane) {
    f32x4 gv[4], bv[4];
#pragma unroll
    for (int j = 0; j < 4; ++j) { gv[j] = *((const f32x4*)g + lane + 64 * j); bv[j] = *((const f32x4*)b + lane + 64 * j); }
    for (int m = gw; m < nrows; m += NGW) {
        const f32x4* xr = (const f32x4*)(zx + (size_t)m * DM) + lane; f32x4* xw = (f32x4*)(xo + (size_t)m * DM) + lane;
        f32x4 v[4]; float s = 0.f;
#pragma unroll
        for (int j = 0; j < 4; ++j) { v[j] = xr[64 * j]; s += (v[j].x + v[j].y) + (v[j].z + v[j].w); }
        const float mean = wave_sum(s) * (1.f / DM); float s2 = 0.f;
#pragma unroll
        for (int j = 0; j < 4; ++j) { v[j] = v[j] - mean; s2 += (v[j].x * v[j].x + v[j].y * v[j].y) + (v[j].z * v[j].z + v[j].w * v[j].w); }
        const float rstd = 1.f / sqrtf(wave_sum(s2) * (1.f / DM) + LN_EPS);
        u32x2* o8 = (u32x2*)(xb + (size_t)m * DM) + lane;
#pragma unroll
        for (int j = 0; j < 4; ++j) { const f32x4 y = v[j] * rstd * gv[j] + bv[j]; xw[64 * j] = y; u32x2 w; w.x = pk2(y.x, y.y); w.y = pk2(y.z, y.w); o8[64 * j] = w; }
    }
}
__device__ __forceinline__ void phase_init(const float* x, bf16_t* xb, int gw, int NGW, int lane) {
    for (int m = gw; m < MTOT; m += NGW) {
        const f32x4* xr = (const f32x4*)(x + (size_t)m * DM) + lane; u32x2* o8 = (u32x2*)(xb + (size_t)m * DM) + lane;
#pragma unroll
        for (int j = 0; j < 4; ++j) { const f32x4 y = xr[64 * j]; u32x2 w; w.x = pk2(y.x, y.y); w.y = pk2(y.z, y.w); o8[64 * j] = w; }
    }
}

constexpr int LRU_A_OFF = 0, LRU_A_PITCH = 144, LRU_XF_OFF = 18432, LRU_XF_PITCH = 33, LRU_AGG_OFF = 18432 + 128 * 33 * 4  , LRU_CARRY_OFF = LRU_AGG_OFF + 8 * 32 * 8;
__device__ __forceinline__ void lru_item(const Args& a, int l, int item, LAS unsigned char* lds, const bf16_t* P, bf16_t* Ya, int tid, int wave, int lane) {
    const int bl = item >> 5, hb = (item >> 1) & 15, half = item & 1;
    const int row0 = bl * SEQ, chb = 64 * hb, cho = chb + 32 * half;
    LAS unsigned char* Abuf = lds + LRU_A_OFF; LAS float* xcf = (LAS float*)(lds + LRU_XF_OFF); LAS float* wagg = (LAS float*)(lds + LRU_AGG_OFF); LAS float* carry = (LAS float*)(lds + LRU_CARRY_OFF);
    const int fr = lane & 15, q = lane >> 4;
    bf16x8 bw[4][2];
#pragma unroll
    for (int nt = 0; nt < 4; ++nt) { const float* wsrc = (nt < 2 ? a.in[I_WRG] : a.in[I_WIG]) + ((size_t)(l * 16 + hb) * 64) * 64 + 32 * half + 16 * (nt & 1) + fr;
#pragma unroll
        for (int ks = 0; ks < 2; ++ks) { unsigned w[4];
#pragma unroll
            for (int j = 0; j < 4; ++j) { const int k = 32 * ks + 8 * q + 2 * j; w[j] = pk2(wsrc[(size_t)k * 64], wsrc[(size_t)(k + 1) * 64]); }
            bw[nt][ks] = __builtin_bit_cast(bf16x8, (u32x4){w[0], w[1], w[2], w[3]}); } }
    float brg[2], big[2], sp[2];
#pragma unroll
    for (int cc = 0; cc < 2; ++cc) { const int ch = cho + 16 * cc + fr; brg[cc] = a.in[I_BRG][l * DM + ch]; big[cc] = a.in[I_BIG][l * DM + ch];
        sp[cc] = 8.0f * log1pf(expf(-a.in[I_LAM][l * DM + ch])); }
    const int cp = tid & 31, tg = tid >> 5; const int cch = chb + 2 * cp;
    float cw[4][2], cb[2];
#pragma unroll
    for (int j = 0; j < 4; ++j) { cw[j][0] = a.in[I_CONVW][(l * 4 + j) * DM + cch]; cw[j][1] = a.in[I_CONVW][(l * 4 + j) * DM + cch + 1]; }
    cb[0] = a.in[I_CONVB][l * DM + cch]; cb[1] = a.in[I_CONVB][l * DM + cch + 1];
    if (tid < 64) carry[tid] = 0.f;
    for (int tile = 0; tile < SEQ / 128; ++tile) {
        const int t0 = tile * 128, par = tile & 1;
        {
            float xv[11][2];
#pragma unroll
            for (int j = 0; j < 11; ++j) { const int t = t0 + 8 * tg - 3 + j; unsigned w = 0u; if (t >= 0) w = *(const unsigned*)(P + (size_t)(row0 + t) * INW + C_LX + cch); xv[j][0] = bf_lo(w); xv[j][1] = bf_hi(w); }
#pragma unroll
            for (int i = 0; i < 8; ++i) { float x0 = cb[0], x1 = cb[1];
#pragma unroll
                for (int j = 0; j < 4; ++j) { x0 += cw[j][0] * xv[i + j][0]; x1 += cw[j][1] * xv[i + j][1]; }
                const int tt = 8 * tg + i;
                *(LAS unsigned*)(Abuf + tt * LRU_A_PITCH + 4 * cp) = pk2(x0, x1);
                if ((cp >> 4) == half) { xcf[tt * LRU_XF_PITCH + 2 * (cp & 15)] = x0; xcf[tt * LRU_XF_PITCH + 2 * (cp & 15) + 1] = x1; } }
        }
        LDS_WAIT(); __syncthreads();
        f32x4 acc[4];
#pragma unroll
        for (int nt = 0; nt < 4; ++nt) acc[nt] = (f32x4){0.f, 0.f, 0.f, 0.f};
#pragma unroll
        for (int ks = 0; ks < 2; ++ks) { const bf16x8 af = *(const LAS bf16x8*)(Abuf + (16 * wave + fr) * LRU_A_PITCH + 64 * ks + 16 * q);
#pragma unroll
            for (int nt = 0; nt < 4; ++nt) acc[nt] = __builtin_amdgcn_mfma_f32_16x16x32_bf16(af, bw[nt][ks], acc[nt], 0, 0, 0); }
        bf16_t gt[2][4];
#pragma unroll
        for (int cc = 0; cc < 2; ++cc)
#pragma unroll
            for (int i = 0; i < 4; ++i) gt[cc][i] = P[(size_t)(row0 + t0 + 16 * wave + 4 * q + i) * INW + C_LG + cho + 16 * cc + fr];
        float A_[2][4], H_[2][4], Ae[2], He[2];
#pragma unroll
        for (int cc = 0; cc < 2; ++cc) {
            float av[4], bv[4];
#pragma unroll
            for (int i = 0; i < 4; ++i) { const int tt = 16 * wave + 4 * q + i;
                const float r = sigm(acc[cc][i] + brg[cc]), ig = sigm(acc[cc + 2][i] + big[cc]);
                const float la = -r * sp[cc];
                av[i] = ex2(la * LOG2E); const float mult = __builtin_amdgcn_sqrtf(1.0f - av[i] * av[i]);
                bv[i] = mult * ig * xcf[tt * LRU_XF_PITCH + 16 * cc + fr]; }
            H_[cc][0] = bv[0]; A_[cc][0] = av[0];
#pragma unroll
            for (int i = 1; i < 4; ++i) { H_[cc][i] = av[i] * H_[cc][i - 1] + bv[i]; A_[cc][i] = av[i] * A_[cc][i - 1]; }
            float Ag = A_[cc][3], Hg = H_[cc][3];
            float t = __shfl_up(Ag, 16), u = __shfl_up(Hg, 16); if (q >= 1) { Hg = Ag * u + Hg; Ag = Ag * t; }
            t = __shfl_up(Ag, 32); u = __shfl_up(Hg, 32); if (q >= 2) { Hg = Ag * u + Hg; Ag = Ag * t; }
            t = __shfl_up(Ag, 16); u = __shfl_up(Hg, 16); Ae[cc] = q ? t : 1.0f; He[cc] = q ? u : 0.0f;
            if (q == 3) { wagg[(wave * 32 + 16 * cc + fr) * 2] = Ag; wagg[(wave * 32 + 16 * cc + fr) * 2 + 1] = Hg; }
        }
        LDS_WAIT(); __syncthreads();
#pragma unroll
        for (int cc = 0; cc < 2; ++cc) { const int c = 16 * cc + fr;
            float hin = carry[par * 32 + c];
            for (int w2 = 0; w2 < wave; ++w2) hin = wagg[(w2 * 32 + c) * 2] * hin + wagg[(w2 * 32 + c) * 2 + 1];
            const float hl = Ae[cc] * hin + He[cc];
#pragma unroll
            for (int i = 0; i < 4; ++i) { const float hv = A_[cc][i] * hl + H_[cc][i];
                if (i == 3 && wave == 7 && q == 3) carry[(par ^ 1) * 32 + c] = hv;
                const float gx = bf2f(gt[cc][i]); const float uu = 0.7978845608028654f * (gx + 0.044715f * gx * gx * gx);
                const float yv = hv * gx * sigm(2.0f * uu);
                Ya[(size_t)(row0 + t0 + 16 * wave + 4 * q + i) * DM + cho + c] = (bf16_t)f2bf(yv); } }
    }
    LDS_WAIT(); __syncthreads();
}

enum { M_BAND = 0, M_NONE = 1, M_BGEN = 2, M_BNEAR = 3, M_BFAR = 4 };
template <int MODE>
__device__ __forceinline__ void attn_tile(f32x16& o0, f32x16& o1, float& m, float& lsum, const bf16x8 (&kc)[4], const bf16x8 (&qf)[4], const int dbase,
                                          const float (&bonus)[4], const float (&farv)[4], LAS unsigned char* vb, const int vroff) {
    constexpr float CS = 0.125f * LOG2E;
    const float NINF = -__builtin_inff();
    f32x16 s;
#pragma unroll
    for (int i = 0; i < 16; ++i) s[i] = 0.f;
#pragma unroll
    for (int ks = 0; ks < 4; ++ks) s = __builtin_amdgcn_mfma_f32_32x32x16_bf16(kc[ks], qf[ks], s, 0, 0, 0);
    float mx = -1e30f;
#pragma unroll
    for (int i = 0; i < 16; ++i) { const int ci = (i & 3) + 8 * (i >> 2);
        if (MODE == M_NONE) s[i] = s[i] * CS;
        else { float lw;
            if (MODE == M_BAND) { const int dlt = dbase - ci; lw = ((unsigned)dlt <= 128u) ? 0.f : NINF; }
            else if (MODE == M_BGEN) { const int dlt = dbase - 4 * ci; lw = ((unsigned)dlt <= 512u) ? bonus[i & 3] : (dlt >= 0 ? farv[i & 3] : NINF); }
            else if (MODE == M_BNEAR) lw = bonus[i & 3];
            else lw = farv[i & 3];
            s[i] = s[i] * CS + lw; }
        mx = fmaxf(mx, s[i]); }
    mx = fmaxf(mx, __shfl_xor(mx, 32));
    const float mn = fmaxf(m, mx); const float alpha = ex2(m - mn);
    float rs = 0.f;
#pragma unroll
    for (int i = 0; i < 16; ++i) { s[i] = ex2(s[i] - mn); rs += s[i]; }
    lsum = lsum * alpha + rs;
    if (__builtin_amdgcn_ballot_w64(mn > m) != 0ull) {
#pragma unroll
        for (int i = 0; i < 16; ++i) { o0[i] *= alpha; o1[i] *= alpha; } }
    m = mn;
    bf16x8 pf[2];
#pragma unroll
    for (int sb = 0; sb < 2; ++sb) { u32x4 w; w.x = pk2(s[8 * sb + 0], s[8 * sb + 1]); w.y = pk2(s[8 * sb + 2], s[8 * sb + 3]); w.z = pk2(s[8 * sb + 4], s[8 * sb + 5]); w.w = pk2(s[8 * sb + 6], s[8 * sb + 7]);
        pf[sb] = __builtin_bit_cast(bf16x8, w); }
    LDS_WAIT();
#pragma unroll
    for (int dt = 0; dt < 2; ++dt)
#pragma unroll
        for (int sb = 0; sb < 2; ++sb) {
            const s16x4 v0 = __builtin_bit_cast(s16x4, __builtin_amdgcn_ds_read_tr16_b64_v4i16((LAS s16x4*)(vb + vroff + dt * 2048 + sb * 1024)));
            const s16x4 v1 = __builtin_bit_cast(s16x4, __builtin_amdgcn_ds_read_tr16_b64_v4i16((LAS s16x4*)(vb + vroff + dt * 2048 + sb * 1024 + 512)));
            const bf16x8 vf = (bf16x8){v0[0], v0[1], v0[2], v0[3], v1[0], v1[1], v1[2], v1[3]};
            if (dt == 0) o0 = __builtin_amdgcn_mfma_f32_32x32x16_bf16(vf, pf[sb], o0, 0, 0, 0);
            else o1 = __builtin_amdgcn_mfma_f32_32x32x16_bf16(vf, pf[sb], o1, 0, 0, 0);
        }
}
__device__ __forceinline__ void attn_item(const bf16_t* __restrict__ P, bf16_t* __restrict__ Y, int row0, int qcol, int kcol, int vcol, int ycol, int tq, int tq0,
                                          int a0, int nA, int r4, int nB, float sink2, bool has_sink, LAS unsigned char* vb, int lane) {
    const int r = lane & 31, h = lane >> 5;
    bf16x8 qf[4];
    { const bf16_t* qp = P + (size_t)(row0 + tq) * INW + qcol + 8 * h;
#pragma unroll
      for (int ks = 0; ks < 4; ++ks) qf[ks] = *(const bf16x8*)(qp + 16 * ks); }
    f32x16 o0, o1;
#pragma unroll
    for (int i = 0; i < 16; ++i) { o0[i] = 0.f; o1[i] = 0.f; }
    float m = -1e30f, lsum = 0.f;
    float bonus[4], farv[4];
#pragma unroll
    for (int k = 0; k < 4; ++k) { bonus[k] = (k == (lane & 3)) ? 1.0f : 0.0f; farv[k] = (k == (lane & 3)) ? 0.0f : -__builtin_inff(); }
    const int nT = nA + nB, blk = nB - 1;
    bf16x8 kf[4], vr[4];
    const int vrow = lane >> 3, vc = lane & 7;
    const unsigned lk1 = (unsigned)((r * INW + kcol + 8 * h) * 2), lk4 = (unsigned)((4 * r * INW + kcol + 8 * h) * 2);
    const unsigned lv1 = (unsigned)((vrow * INW + vcol + 8 * vc) * 2), lv4 = (unsigned)((4 * vrow * INW + vcol + 8 * vc) * 2);
#define ATT_LOAD(ti) do { const bool sb_ = (ti) >= nA; const int kt0_ = sb_ ? r4 + 128 * ((ti) - nA) : a0 + 32 * (ti); \
        const char* pb_ = (const char*)P + (size_t)(unsigned)(row0 + kt0_) * (unsigned)(INW * 2); \
        const unsigned lk_ = sb_ ? lk4 : lk1, lv_ = sb_ ? lv4 : lv1, vs_ = sb_ ? (unsigned)(32 * INW * 2) : (unsigned)(8 * INW * 2); \
        _Pragma("unroll") for (int ks = 0; ks < 4; ++ks) kf[ks] = *(const bf16x8*)(pb_ + lk_ + 32 * ks); \
        _Pragma("unroll") for (int i = 0; i < 4; ++i) vr[i] = *(const bf16x8*)(pb_ + lv_ + i * vs_); } while (0)
    ATT_LOAD(0);
    const int vwoff = (vc >> 2) * 2048 + vrow * 64 + (vc & 3) * 16;
    const int g = lane >> 4, idx = lane & 15;
    const int vroff = (4 * h + (idx >> 2)) * 64 + 32 * (g & 1) + 8 * (idx & 3);
    for (int ti = 0; ti < nT; ++ti) {
        const bool sweepB = ti >= nA;
        const int kt0 = sweepB ? r4 + 128 * (ti - nA) : a0 + 32 * ti;
        asm volatile("" ::: "memory");
#pragma unroll
        for (int i = 0; i < 4; ++i) *(LAS bf16x8*)(vb + vwoff + i * 512) = vr[i];
        bf16x8 kc[4];
#pragma unroll
        for (int ks = 0; ks < 4; ++ks) kc[ks] = kf[ks];
        if (ti + 1 < nT) ATT_LOAD(ti + 1);
        if (!sweepB) {
            const int du = tq0 - kt0;
            const int dbase = tq - kt0 - 4 * h;
            if (has_sink && (du == 32 || du == 64 || du == 96)) attn_tile<M_NONE>(o0, o1, m, lsum, kc, qf, dbase, bonus, farv, vb, vroff);
            else attn_tile<M_BAND>(o0, o1, m, lsum, kc, qf, dbase, bonus, farv, vb, vroff);
        } else {
            const int d = blk - (ti - nA);
            const int dbase = tq - kt0 - 16 * h;
            if (d >= 5) attn_tile<M_BFAR>(o0, o1, m, lsum, kc, qf, dbase, bonus, farv, vb, vroff);
            else if (d >= 1 && d <= 3) attn_tile<M_BNEAR>(o0, o1, m, lsum, kc, qf, dbase, bonus, farv, vb, vroff);
            else attn_tile<M_BGEN>(o0, o1, m, lsum, kc, qf, dbase, bonus, farv, vb, vroff);
        }
        asm volatile("" ::: "memory");
    }
#undef ATT_LOAD
    lsum += __shfl_xor(lsum, 32);
    float scale;
    if (has_sink) { const float mf = fmaxf(m, sink2); const float al = ex2(m - mf); scale = al * rcpf_(lsum * al + ex2(sink2 - mf)); }
    else scale = rcpf_(lsum);
    bf16_t* yp = Y + (size_t)(row0 + tq) * DM + ycol + 4 * h;
#pragma unroll
    for (int g4 = 0; g4 < 4; ++g4) {
        u32x2 w0; w0.x = pk2(o0[4 * g4] * scale, o0[4 * g4 + 1] * scale); w0.y = pk2(o0[4 * g4 + 2] * scale, o0[4 * g4 + 3] * scale); *(u32x2*)(yp + 8 * g4) = w0;
        u32x2 w1; w1.x = pk2(o1[4 * g4] * scale, o1[4 * g4 + 1] * scale); w1.y = pk2(o1[4 * g4 + 2] * scale, o1[4 * g4 + 3] * scale); *(u32x2*)(yp + 32 + 8 * g4) = w1;
    }
}

__device__ __forceinline__ void phase_mixer(const Args& a, int l, LAS unsigned char* lds, const bf16_t* P, bf16_t* Yb, int tid, int wave, int lane, int parts) {
    if (parts & 1) for (int item = blockIdx.x; item < SEQ_PER_CH * 32; item += gridDim.x) lru_item(a, l, item, lds, P, Yb, tid, wave, lane);
    LAS unsigned char* vb = lds + wave * 4096;
    const int W = blockIdx.x * 8 + wave, NW = gridDim.x * 8;
    if (parts & 2) for (int it = W; it < SEQ_PER_CH * 16 * 64; it += NW) {
        const int bl = it >> 10, hq = (it >> 6) & 15, blk = it & 63; const int t0 = 32 * blk;
        const int a0 = t0 >= 128 ? t0 - 128 : 0, nA = (t0 + 32 - a0) >> 5;
        attn_item(P, Yb + (size_t)MC * DM, bl * SEQ, C_QB + 64 * hq, C_KB + 64 * (hq >> 2), C_VB + 64 * (hq >> 2), 64 * hq, t0 + (lane & 31), t0, a0, nA, 0, 0,
                  a.in[I_SINK][l * 16 + hq] * LOG2E, true, vb, lane);
    }
    if (parts & 4) for (int wk = W; wk < SEQ_PER_CH * 16 * 16; wk += NW) {
        const int bl = wk >> 8, hq = (wk >> 4) & 15, pg = wk & 15, r4 = pg & 3, aa = pg >> 2;
#pragma unroll 1
        for (int k = 0; k < 4; ++k) {
            const int blk = (k == 0) ? aa : (k == 1) ? 7 - aa : (k == 2) ? 8 + aa : 15 - aa; const int T0 = 128 * blk;
            const int a0 = T0 >= 128 ? T0 - 128 : 0, nA = (T0 + 128 - a0) >> 5, nB = blk + 1;
            attn_item(P, Yb + (size_t)2 * MC * DM, bl * SEQ, C_QC + 64 * hq, C_KC + 64 * hq, C_VC + 64 * hq, 64 * hq, T0 + r4 + 4 * (lane & 31), T0 + r4, a0, nA, r4, nB, 0.f, false, vb, lane);
        }
    }
}


#define XB_TMO      128
#define XB_XCNT(j)  (256  + 64 * (j))
#define XB_XSUB(j)  (1280 + 64 * (j))
#define XB_XGEN(j)  (2304 + 64 * (j))
#define XB_TOP      3328
#define XB_TOPGEN   3392
#define XCD_BAR_WORDS 3456
#define XB_SPIN_CAP (1u << 18)
__device__ __forceinline__ unsigned xb_ld(unsigned* p)              { return __hip_atomic_load(p, __ATOMIC_RELAXED, __HIP_MEMORY_SCOPE_AGENT); }
__device__ __forceinline__ unsigned xb_add(unsigned* p, unsigned v) { return __hip_atomic_fetch_add(p, v, __ATOMIC_RELAXED, __HIP_MEMORY_SCOPE_AGENT); }
__device__ __forceinline__ unsigned xb_xcc_id() { return (unsigned)__builtin_amdgcn_s_getreg((3 << 11) | 20) & 0xFu; }
#define XB_SPIN(cond, bar) do { unsigned _sp = 0; while (cond) { __builtin_amdgcn_s_sleep(1); \
    if ((++_sp & 255u) == 0u) { if (xb_ld(&(bar)[XB_TMO])) break; if (_sp > XB_SPIN_CAP) { atomicAdd(&(bar)[XB_TMO], 1u); break; } } } } while (0)
struct XcdBarrier { unsigned* bar; unsigned x; volatile LAS unsigned* st; };
__device__ __forceinline__ XcdBarrier xcd_barrier_post(unsigned* bar, volatile LAS unsigned* st) {
    XcdBarrier b; b.bar = bar; b.x = xb_xcc_id(); b.st = st;
    if (threadIdx.x == 0) (void)xb_add(&bar[XB_XCNT(b.x)], 1u);
    return b;
}
__device__ __forceinline__ void xcd_barrier_complete(unsigned* bar, unsigned x, unsigned& nloc, unsigned& nx) {
    const unsigned G = gridDim.x * gridDim.y * gridDim.z;
    unsigned sum, cnt, mine, sp = 0u;
    for (;;) {
        sum = 0u; cnt = 0u; mine = 0u;
#pragma unroll
        for (unsigned j = 0; j < 16; ++j) { const unsigned c = xb_ld(&bar[XB_XCNT(j)]); sum += c; cnt += (c > 0u) ? 1u : 0u; mine = (j == x) ? c : mine; }
        if (sum == G) break;
        __builtin_amdgcn_s_sleep(1);
        if ((++sp & 255u) == 0u) { if (xb_ld(&bar[XB_TMO])) break; if (sp > XB_SPIN_CAP) { atomicAdd(&bar[XB_TMO], 1u); break; } }
    }
    nloc = mine > 0u ? mine : 1u; nx = cnt > 0u ? cnt : 1u;
}
__device__ __forceinline__ void xcd_barrier(const XcdBarrier& b) {
    asm volatile("s_waitcnt vmcnt(0)" ::: "memory");
    __syncthreads();
    if (threadIdx.x == 0) {
        unsigned* bar = b.bar;
        __builtin_amdgcn_s_waitcnt(0);
        unsigned nloc = b.st[0], nx = b.st[1];
        if (nloc == 0u) { xcd_barrier_complete(bar, b.x, nloc, nx); b.st[0] = nloc; b.st[1] = nx; }
        const unsigned old = xb_add(&bar[XB_XSUB(b.x)], 1u);
        const unsigned gen = old / nloc;
        if (old + 1u == (gen + 1u) * nloc) {
            __builtin_amdgcn_fence(__ATOMIC_RELEASE, "agent");
            asm volatile("s_waitcnt vmcnt(0)" ::: "memory");
            const unsigned og = xb_add(&bar[XB_TOP], 1u);
            const unsigned tg = og / nx;
            if (og + 1u == (tg + 1u) * nx) xb_add(&bar[XB_TOPGEN], 1u);
            else XB_SPIN(xb_ld(&bar[XB_TOPGEN]) == tg, bar);
            __builtin_amdgcn_fence(__ATOMIC_ACQUIRE, "agent");
            xb_add(&bar[XB_XGEN(b.x)], 1u);
            asm volatile("s_waitcnt vmcnt(0)" ::: "memory");
        } else {
            XB_SPIN(xb_ld(&bar[XB_XGEN(b.x)]) == gen, bar);
            __builtin_amdgcn_fence(__ATOMIC_ACQUIRE, "agent");
            asm volatile("s_waitcnt vmcnt(0)" ::: "memory");
        }
    }
    __syncthreads();
}

__global__ void __launch_bounds__(512, 2) mega_fwd(Args a) {
    extern __shared__ __attribute__((aligned(16))) unsigned char lds_raw[];
    LAS unsigned char* lds = (LAS unsigned char*)lds_raw;
    const int tid = threadIdx.x, lane = tid & 63, wave = __builtin_amdgcn_readfirstlane(tid >> 6);
    const int G = gridDim.x, gw = blockIdx.x * 8 + wave, NGW = G * 8;
    unsigned char* ws = a.ws;
    bf16_t* XB = (bf16_t*)(ws + WS_XB); bf16_t* PROJ = (bf16_t*)(ws + WS_PROJ); bf16_t* YB = (bf16_t*)(ws + WS_Y); bf16_t* MRG = (bf16_t*)(ws + WS_MRG); bf16_t* HB = (bf16_t*)(ws + WS_H);
    cg::grid_group grid = cg::this_grid();
    volatile LAS unsigned* MISC = (volatile LAS unsigned*)(lds + 131072);
    if (tid < 64) MISC[tid] = 0u;
    __syncthreads();
    unsigned* barw = (unsigned*)(ws + WS_CTL);
    XcdBarrier bar; bar.bar = barw; bar.x = 0; bar.st = MISC + 8;
    const bool multi_phase = (a.ph_hi - a.ph_lo) > 1;
    if (multi_phase) {
        for (int i = blockIdx.x * 512 + tid; i < XCD_BAR_WORDS; i += G * 512) barw[i] = 0u;
        grid.sync();
        bar = xcd_barrier_post(barw, MISC + 8);
    }
    const int tid0 = tid, lane0 = lane;
#pragma unroll 1
    for (int ph = a.ph_lo; ph < a.ph_hi; ++ph) {
        if (ph > a.ph_lo) { if (PROBE_ST == 11) grid.sync(); else xcd_barrier(bar); if (PROBE_ST == 9) { for (int r9 = 0; r9 < PROBE_REP; ++r9) xcd_barrier(bar); } }
        int tid = tid0, lane = lane0; asm volatile("" : "+v"(tid), "+v"(lane));
        if (ph == 0) { phase_init(a.in[I_X], XB, gw, NGW, lane); continue; }
        const int qq = ph - 1, l = qq / 17, rr = qq % 17;
        if (rr == 0) { for (int r8 = 0; r8 <= (PROBE_ST == 8 ? PROBE_REP : 0); ++r8) phase_weights(a, l, ws, lds, gw, NGW, wave, lane); if (PROBE_ST == 10) phase_weights(a, (l + 2) & 3, ws + WS_END, lds, gw, NGW, wave, lane); continue; }
        const int c = (rr - 1) >> 3, st = (rr - 1) & 7;
        const size_t crow = (size_t)c * MC;
        float* xres = a.out + crow * DM; bf16_t* xb = XB + crow * DM;
        const int nrep = (st == PROBE_ST || st + 20 == PROBE_ST) ? PROBE_REP : 0;
#pragma unroll 1
        for (int rep = 0; rep <= nrep; ++rep) {
        float* xdst = (rep < nrep) ? (float*)(ws + WS_END) : xres;
        if (rep) { if (PROBE_ST >= 20) xcd_barrier(bar); else __syncthreads(); }
        int tid = tid0, lane = lane0; asm volatile("" : "+v"(tid), "+v"(lane));
        if (st == 0 && (PH_MASK & 1)) {
            pg8::StaticOrder S; S.init(MC, INW, G, (int)blockIdx.x); pg8::EpiProj E{PROJ, INW};
            pg8::gemm_phase(lds, xb, DM, (const bf16_t*)(ws + WS_WIN), DM, S, E, tid);
        } else if (st == 1 && (PH_MASK & 2)) {
            phase_mixer(a, l, lds, PROJ, YB, tid, wave, lane, 7);
            if (PROBE_ST >= 30 && PROBE_ST <= 32) { __syncthreads(); phase_mixer(a, l, lds, PROJ, YB, tid, wave, lane, 1 << (PROBE_ST - 30)); }
        } else if (st == 2 && (PH_MASK & 4)) {
            pg8::BranchOrder S; S.init(G, (int)blockIdx.x); pg8::EpiBranch E{PROJ, MRG};
            pg8::gemm_phase(lds, YB, DM, (const bf16_t*)(ws + WS_WBR), DM, S, E, tid);
        } else if (st == 3 && (PH_MASK & 8)) {
            pg8::StaticOrder S; S.init(MC, DM, G, (int)blockIdx.x); pg8::EpiResid E{(l == 0 ? a.in[I_X] : a.out) + crow * DM, xdst};
            pg8::gemm_phase(lds, MRG, DM, (const bf16_t*)(ws + WS_WOUT), DM, S, E, tid);
        } else if (st == 4 && (PH_MASK & 16)) {
            phase_ln(xres, xdst, xb, a.in[I_LN1G] + l * DM, a.in[I_LN1B] + l * DM, MC, gw, NGW, lane);
        } else if (st == 5 && (PH_MASK & 32)) {
            pg8::StaticOrder S; S.init(MC, FF2, G, (int)blockIdx.x); pg8::EpiSwiGLU E{HB};
            pg8::gemm_phase(lds, xb, DM, (const bf16_t*)(ws + WS_WF1), DM, S, E, tid);
        } else if (st == 6 && (PH_MASK & 64)) {
            pg8::StaticOrder S; S.init(MC, DM, G, (int)blockIdx.x); pg8::EpiResid E{xres, xdst};
            pg8::gemm_phase(lds, HB, FFH, (const bf16_t*)(ws + WS_WF2), FFH, S, E, tid);
        } else if (PH_MASK & 128) {
            phase_ln(xres, xdst, xb, a.in[I_LN2G] + l * DM, a.in[I_LN2B] + l * DM, MC, gw, NGW, lane);
        }
        }
    }
}

extern "C" void kernel_launch(void* const* d_in, const int* in_sizes, int n_in, void* d_out, int out_size, void* d_ws, size_t ws_size, hipStream_t stream) {
    static int grid = 0;
    if (grid == 0) {
        if (n_in != 18 || out_size != MTOT * DM || ws_size < WS_NEED) { fprintf(stderr, "kernel_launch: unexpected shapes (n_in %d out %d ws %zu)\n", n_in, out_size, ws_size); grid = -1; return; }
        int dev = 0, cus = 0, per_cu = 0;
        hipGetDevice(&dev); hipDeviceGetAttribute(&cus, hipDeviceAttributeMultiprocessorCount, dev);
        if (hipFuncSetAttribute((const void*)mega_fwd, hipFuncAttributeMaxDynamicSharedMemorySize, LDS_BYTES) != hipSuccess) { fprintf(stderr, "kernel_launch: hipFuncSetAttribute failed\n"); grid = -1; return; }
        if (hipOccupancyMaxActiveBlocksPerMultiprocessor(&per_cu, (const void*)mega_fwd, 512, LDS_BYTES) != hipSuccess || per_cu < 1) { fprintf(stderr, "kernel_launch: occupancy query says %d\n", per_cu); per_cu = 1; }
        (void)hipGetLastError();
        grid = cus * per_cu;
    }
    if (grid < 0) return;
    Args a{};
    for (int i = 0; i < 18; ++i) a.in[i] = (const float*)d_in[i];
    a.out = (float*)d_out; a.ws = (unsigned char*)d_ws;
#if MK_MULTI
    for (int ph = 0; ph < NPH; ++ph) { a.ph_lo = ph; a.ph_hi = ph + 1; hipLaunchKernelGGL(mega_fwd, dim3(grid), dim3(512), LDS_BYTES, stream, a); }
#else
    a.ph_lo = 0; a.ph_hi = NPH;
    void* args[] = {&a};
    hipError_t e = hipLaunchCooperativeKernel((const void*)mega_fwd, dim3(grid), dim3(512), args, LDS_BYTES, stream);
    if (e != hipSuccess) fprintf(stderr, "cooperative launch failed: %s (grid %d)\n", hipGetErrorString(e), grid);
#endif
}
```

```cpp
#include <hip/hip_runtime.h>
#include <hip/hip_cooperative_groups.h>
#include <cstdio>
namespace cg = cooperative_groups;

#ifndef MK_MULTI
#define MK_MULTI 0
#endif

#ifndef PROBE_ST
#define PROBE_ST -1
#define PROBE_REP 0
#endif
#ifndef PH_MASK
#define PH_MASK 255
#endif
#define LAS __attribute__((address_space(3)))
typedef unsigned short bf16_t;
typedef short bf16x8 __attribute__((ext_vector_type(8)));
typedef short s16x4 __attribute__((ext_vector_type(4)));
typedef float f32x4 __attribute__((ext_vector_type(4)));
typedef float f32x16 __attribute__((ext_vector_type(16)));
typedef unsigned u32x4 __attribute__((ext_vector_type(4)));
typedef unsigned u32x2 __attribute__((ext_vector_type(2)));

constexpr int DM = 1024, SEQ = 2048, BATCH = 16, DEPTH = 4, INW = 9728, FFH = 2816, FF2 = 5632;
constexpr int NCH = 2, MC = 16384, SEQ_PER_CH = 8, MTOT = BATCH * SEQ;
constexpr int C_LX = 0, C_LG = 1024, C_QB = 2048, C_KB = 3072, C_VB = 3328, C_QC = 3584, C_KC = 4608, C_VC = 5632, C_GATE = 6656;
constexpr float LN_EPS = 1e-5f;
constexpr float ALPHA = 1.681792830507429f;
constexpr float LOG2E = 1.4426950408889634f;
constexpr size_t MiB = 1u << 20;
constexpr size_t WS_WIN = 0, WS_WBR = 19 * MiB, WS_WOUT = 25 * MiB, WS_WF1 = 27 * MiB, WS_WF2 = 38 * MiB, WS_XB = 44 * MiB, WS_PROJ = 108 * MiB,
                 WS_Y = 412 * MiB, WS_MRG = 508 * MiB, WS_END = 540 * MiB, WS_H = WS_PROJ, WS_CTL = 604 * MiB  , WS_NEED = 605 * MiB;
constexpr int LDS_BYTES = 147456;
constexpr int NPH = 1 + DEPTH * 17;

__device__ __forceinline__ unsigned f2bf(float f) { unsigned u = __builtin_bit_cast(unsigned, f); return (u + 0x7fffu + ((u >> 16) & 1u)) >> 16; }
__device__ __forceinline__ unsigned pk2(float lo, float hi) { unsigned r; asm volatile("v_cvt_pk_bf16_f32 %0, %1, %2" : "=v"(r) : "v"(lo), "v"(hi)); return r; }
__device__ __forceinline__ float bf_lo(unsigned w) { return __builtin_bit_cast(float, w << 16); }
__device__ __forceinline__ float bf_hi(unsigned w) { return __builtin_bit_cast(float, w & 0xffff0000u); }
__device__ __forceinline__ float bf2f(bf16_t b) { return __builtin_bit_cast(float, ((unsigned)b) << 16); }
__device__ __forceinline__ float ex2(float x) { return __builtin_amdgcn_exp2f(x); }
__device__ __forceinline__ float rcpf_(float x) { return __builtin_amdgcn_rcpf(x); }
__device__ __forceinline__ float sigm(float x) { return rcpf_(1.0f + ex2(-x * LOG2E)); }
__device__ __forceinline__ float wave_sum(float v) {
#pragma unroll
    for (int o = 1; o < 64; o <<= 1) v += __shfl_xor(v, o);
    return v;
}
#define LDS_WAIT() asm volatile("s_waitcnt lgkmcnt(0)" ::: "memory")

namespace pg8 {
constexpr int BM = 256, BK = 64, HALF = 128, HTB = HALF * BK * 2, STAGE_BYTES = 8 * HTB, NXCD = 8, WGM = 8;
__host__ __device__ __forceinline__ int lds_byte(int r, int c) { const int st = (r >> 4) * 2 + (c >> 5), rr = r & 15, cc = c & 31, ob = rr * 64 + cc * 2; return st * 1024 + (ob ^ (((ob >> 9) & 1) << 5)); }
__host__ __device__ __forceinline__ void stage_rc(int b, int& R, int& C) { const int st = b / 1024, sb = b % 1024, swz = sb ^ (((sb >> 9) & 1) << 5); R = (st >> 1) * 16 + swz / 64; C = (st & 1) * 32 + (swz % 64) / 2; }
__host__ __device__ __forceinline__ int perm32(int rho) { const int n = rho >> 4, i = rho & 15; return 8 * (i >> 2) + 4 * n + (i & 3); }
struct Unit { int pm, pn; };
struct StaticOrder {
    int nM, nN, nwg, G, c;
    __device__ void init(int M, int N, int G_, int c_) { nM = M / BM; nN = N / BM; nwg = nM * nN; G = G_; c = c_; }
    __device__ bool next(int i, Unit& u) const {
        const long L = (long)i * G + c; if (L >= nwg) return false;
        int wgid = (int)L; { const int q = nwg / NXCD, r = nwg % NXCD, xcd = wgid % NXCD, off = wgid / NXCD; wgid = (xcd < r ? xcd * (q + 1) : r * (q + 1) + (xcd - r) * q) + off; }
        const int nig = WGM * nN, gid = wgid / nig, fm = gid * WGM, gsz = (nM - fm) < WGM ? (nM - fm) : WGM;
        u.pm = fm + ((wgid % nig) % gsz); u.pn = (wgid % nig) / gsz; return true;
    }
};
struct BranchOrder {
    StaticOrder so;
    __device__ void init(int G_, int c_) { so.init(MC, DM, G_, c_); }
    __device__ bool next(int i, Unit& u) const { const int t = i / 3, n = i - 3 * t; Unit b; if (!so.next(t, b)) return false; u.pm = n * (MC / BM) + b.pm; u.pn = n * (DM / BM) + b.pn; return true; }
};

typedef f32x4 Acc[2][2][4][2];

struct EpiProj {
    static constexpr bool PERM = true;
    bf16_t* O; int ldc;
    __device__ __forceinline__ bool operator()(Acc& acc, const Unit& u, int wr, int wc, int fr, int fq) const {
        const int row0 = u.pm * BM + wr * 64 + fr, col0 = u.pn * BM + wc * 32 + 8 * fq;
#pragma unroll
        for (int ai = 0; ai < 2; ++ai)
#pragma unroll
            for (int m = 0; m < 4; ++m) { bf16_t* rowp = O + (size_t)(row0 + ai * HALF + m * 16) * ldc + col0;
#pragma unroll
                for (int bj = 0; bj < 2; ++bj) { const f32x4 v0 = acc[ai][bj][m][0], v1 = acc[ai][bj][m][1];
                    u32x4 w; w.x = pk2(v0[0], v0[1]); w.y = pk2(v0[2], v0[3]); w.z = pk2(v1[0], v1[1]); w.w = pk2(v1[2], v1[3]);
                    *(u32x4*)(rowp + bj * HALF) = w; } }
        return false;
    }
};
struct EpiBranch {
    static constexpr bool PERM = true;
    const bf16_t* P; bf16_t* O;
    __device__ __forceinline__ bool operator()(Acc& acc, const Unit& u, int wr, int wc, int fr, int fq) const {
        const int n = u.pn >> 2, pn = u.pn & 3, pm = u.pm & 63;
        const int row0 = pm * BM + wr * 64 + fr, col0 = pn * BM + wc * 32 + 8 * fq;
#pragma unroll
        for (int ai = 0; ai < 2; ++ai)
#pragma unroll
            for (int m = 0; m < 4; ++m) { const int row = row0 + ai * HALF + m * 16;
#pragma unroll
                for (int bj = 0; bj < 2; ++bj) {
                    const bf16_t* gp = P + (size_t)row * INW + C_GATE + n * DM + col0 + bj * HALF;
                    const u32x4 ga = *(const u32x4*)gp; u32x4 gb = ga; if (n < 2) gb = *(const u32x4*)(gp + DM);
                    float fa[8], fb[8];
                    fa[0] = bf_lo(ga.x); fa[1] = bf_hi(ga.x); fa[2] = bf_lo(ga.y); fa[3] = bf_hi(ga.y); fa[4] = bf_lo(ga.z); fa[5] = bf_hi(ga.z); fa[6] = bf_lo(ga.w); fa[7] = bf_hi(ga.w);
                    fb[0] = bf_lo(gb.x); fb[1] = bf_hi(gb.x); fb[2] = bf_lo(gb.y); fb[3] = bf_hi(gb.y); fb[4] = bf_lo(gb.z); fb[5] = bf_hi(gb.z); fb[6] = bf_lo(gb.w); fb[7] = bf_hi(gb.w);
                    float v[8];
#pragma unroll
                    for (int j = 0; j < 8; ++j) { const float da = 1.0f + ex2(-fa[j] * LOG2E); const float nb = (n < 2) ? (1.0f + ex2(-fb[j] * LOG2E)) : 1.0f;
                        const float f = nb * rcpf_(da); v[j] = acc[ai][bj][m][j >> 2][j & 3] * f; }
                    acc[ai][bj][m][0] = (f32x4){v[0], v[1], v[2], v[3]}; acc[ai][bj][m][1] = (f32x4){v[4], v[5], v[6], v[7]};
                    if (n == 2) { u32x4 w; w.x = pk2(v[0], v[1]); w.y = pk2(v[2], v[3]); w.z = pk2(v[4], v[5]); w.w = pk2(v[6], v[7]);
                        *(u32x4*)(O + (size_t)row * DM + col0 + bj * HALF) = w; }
                } }
        return n < 2;
    }
};
struct EpiResid {
    static constexpr bool PERM = false;
    const float* src; float* dst;
    __device__ __forceinline__ bool operator()(Acc& acc, const Unit& u, int wr, int wc, int fr, int fq) const {
        const int row0 = u.pm * BM + wr * 64 + fr, col0 = u.pn * BM + wc * 32 + 4 * fq;
#pragma unroll
        for (int ai = 0; ai < 2; ++ai)
#pragma unroll
            for (int m = 0; m < 4; ++m) { const size_t off = (size_t)(row0 + ai * HALF + m * 16) * DM + col0;
#pragma unroll
                for (int bj = 0; bj < 2; ++bj)
#pragma unroll
                    for (int n = 0; n < 2; ++n) { const f32x4 bs = *(const f32x4*)(src + off + bj * HALF + n * 16); *(f32x4*)(dst + off + bj * HALF + n * 16) = bs * ALPHA + acc[ai][bj][m][n]; } }
        return false;
    }
};
struct EpiSwiGLU {
    static constexpr bool PERM = true;
    bf16_t* H;
    __device__ __forceinline__ bool operator()(Acc& acc, const Unit& u, int wr, int wc, int fr, int fq) const {
        const int row0 = u.pm * BM + wr * 64 + fr, col0 = u.pn * 128 + wc * 16 + 4 * fq;
#pragma unroll
        for (int ai = 0; ai < 2; ++ai)
#pragma unroll
            for (int m = 0; m < 4; ++m) { bf16_t* rowp = H + (size_t)(row0 + ai * HALF + m * 16) * FFH + col0;
#pragma unroll
                for (int bj = 0; bj < 2; ++bj) { const f32x4 a = acc[ai][bj][m][0], b = acc[ai][bj][m][1]; float v[4];
#pragma unroll
                    for (int j = 0; j < 4; ++j) v[j] = a[j] * sigm(a[j]) * b[j];
                    u32x2 w; w.x = pk2(v[0], v[1]); w.y = pk2(v[2], v[3]); *(u32x2*)(rowp + bj * 64) = w; } }
        return false;
    }
};

template <class Epi, class Sched>
__device__ __forceinline__ void gemm_phase(LAS unsigned char* lds, const bf16_t* Ab, int lda, const bf16_t* Btb, int K, const Sched& S, const Epi& E, const int tid) {
    const int wid = __builtin_amdgcn_readfirstlane(tid >> 6), lane = tid & 63, wr = wid >> 2, wc = wid & 3, fr = lane & 15, fq = lane >> 4;
    const int nt = K / BK;
    unsigned voffA[2], voffB[2];
#pragma unroll
    for (int i = 0; i < 2; ++i) { int R, C; stage_rc(tid * 16 + i * 8192, R, C); const int Rb = Epi::PERM ? ((R & ~31) + perm32(R & 31)) : R;
        voffA[i] = (unsigned)(R * lda + C) * 2u; voffB[i] = (unsigned)(Rb * K + C) * 2u; }
    const size_t kstep = (size_t)(BK * 2);
    const size_t hstepA = (size_t)HALF * lda * 2, tstepA = 2 * hstepA, hstepB = (size_t)HALF * K * 2, tstepB = 2 * hstepB;
    const unsigned ldsw = (unsigned)wid * 1024u;
    const int aoff = lds_byte(wr * 64 + fr, fq * 8), boff = lds_byte(wc * 32 + fr, fq * 8);
#define PG8_SA(b, h) (((b) * 2 + (h)) * HTB)
#define PG8_SB(b, h) ((4 + (b) * 2 + (h)) * HTB)
#define PG8_STAGE(bufoff, gbase, voff) do { _Pragma("unroll") for (int _i = 0; _i < 2; ++_i) \
        __builtin_amdgcn_global_load_lds((const unsigned*)((const char*)(gbase) + (voff)[_i]), (LAS unsigned*)(lds + (bufoff) + ldsw + _i * 8192), 16, 0, 0); } while (0)
#define PG8_LDA(dst, b, h) do { _Pragma("unroll") for (int m = 0; m < 4; ++m) _Pragma("unroll") for (int k = 0; k < 2; ++k) dst[m][k] = *(const LAS bf16x8*)(lds + PG8_SA(b, h) + aoff + m * 2048 + k * 1024); } while (0)
#define PG8_LDB(dst, b, h) do { _Pragma("unroll") for (int n = 0; n < 2; ++n) _Pragma("unroll") for (int k = 0; k < 2; ++k) dst[n][k] = *(const LAS bf16x8*)(lds + PG8_SB(b, h) + boff + n * 2048 + k * 1024); } while (0)
#define PG8_MMA(ai, bj, At, Bt) do { __builtin_amdgcn_s_setprio(1); _Pragma("unroll") for (int m = 0; m < 4; ++m) _Pragma("unroll") for (int n = 0; n < 2; ++n) _Pragma("unroll") for (int k = 0; k < 2; ++k) \
        acc[ai][bj][m][n] = __builtin_amdgcn_mfma_f32_16x16x32_bf16(Bt[n][k], At[m][k], acc[ai][bj][m][n], 0, 0, 0); __builtin_amdgcn_s_setprio(0); } while (0)
#define PG8_WAIT_V(n) asm volatile("s_waitcnt vmcnt(" #n ")" ::: "memory")
#define PG8_WAIT_L(n) asm volatile("s_waitcnt lgkmcnt(" #n ")" ::: "memory")
#define PG8_BAR __builtin_amdgcn_s_barrier()
#define PG8_SCHED __builtin_amdgcn_sched_barrier(0)
    Unit cur, nxt; int ui = 0;
    if (!S.next(0, cur)) return;
    Acc acc;
#pragma unroll
    for (int a = 0; a < 2; ++a)
#pragma unroll
        for (int b = 0; b < 2; ++b)
#pragma unroll
            for (int m = 0; m < 4; ++m)
#pragma unroll
                for (int n = 0; n < 2; ++n) acc[a][b][m][n] = (f32x4){0.f, 0.f, 0.f, 0.f};
    bf16x8 At[4][2], B0[2][2], B1[2][2];
    const char* cA = (const char*)Ab + (size_t)cur.pm * tstepA; const char* cB = (const char*)Btb + (size_t)cur.pn * tstepB;
    PG8_STAGE(PG8_SB(0, 0), cB, voffB); PG8_STAGE(PG8_SB(0, 1), cB + hstepB, voffB); PG8_STAGE(PG8_SA(0, 0), cA, voffA); PG8_STAGE(PG8_SA(0, 1), cA + hstepA, voffA);
    if (wr == 1) PG8_BAR;
    PG8_WAIT_V(2); PG8_BAR;
    PG8_STAGE(PG8_SB(1, 0), cB + kstep, voffB); PG8_STAGE(PG8_SA(1, 0), cA + kstep, voffA); PG8_STAGE(PG8_SB(1, 1), cB + hstepB + kstep, voffB);
    PG8_WAIT_V(6); PG8_BAR;
    for (;;) {
        const bool has_next = S.next(ui + 1, nxt);
        const char* nA = has_next ? (const char*)Ab + (size_t)nxt.pm * tstepA : cA; const char* nB = has_next ? (const char*)Btb + (size_t)nxt.pn * tstepB : cB;
        for (int t = 0; t < nt; t += 2) {
            const bool last = (t == nt - 2);
            const char* a1 = cA + (size_t)(t + 1) * kstep;
            const char* a2 = last ? nA : cA + (size_t)(t + 2) * kstep; const char* b2 = last ? nB : cB + (size_t)(t + 2) * kstep;
            const char* a3 = a2 + kstep; const char* b3 = b2 + kstep;
            PG8_LDB(B0, 0, 0); PG8_LDB(B1, 0, 1); PG8_SCHED; PG8_LDA(At, 0, 0); PG8_STAGE(PG8_SA(1, 1), a1 + hstepA, voffA);
            PG8_WAIT_V(8); PG8_WAIT_L(0); PG8_BAR; PG8_MMA(0, 0, At, B0); PG8_MMA(0, 1, At, B1); PG8_BAR; PG8_SCHED;
            PG8_LDA(At, 0, 1); PG8_STAGE(PG8_SB(0, 0), b2, voffB); PG8_STAGE(PG8_SB(0, 1), b2 + hstepB, voffB); PG8_STAGE(PG8_SA(0, 0), a2, voffA);
            PG8_WAIT_V(8); PG8_WAIT_L(0); PG8_BAR; PG8_MMA(1, 0, At, B0); PG8_MMA(1, 1, At, B1); PG8_BAR; PG8_SCHED;
            PG8_LDB(B0, 1, 0); PG8_LDB(B1, 1, 1); PG8_SCHED; PG8_LDA(At, 1, 0); PG8_STAGE(PG8_SA(0, 1), a2 + hstepA, voffA);
            PG8_WAIT_V(8); PG8_WAIT_L(0); PG8_BAR; PG8_MMA(0, 0, At, B0); PG8_MMA(0, 1, At, B1); PG8_BAR; PG8_SCHED;
            PG8_LDA(At, 1, 1); PG8_STAGE(PG8_SB(1, 0), b3, voffB); PG8_STAGE(PG8_SB(1, 1), b3 + hstepB, voffB); PG8_STAGE(PG8_SA(1, 0), a3, voffA);
            PG8_WAIT_V(8); PG8_WAIT_L(0); PG8_BAR; PG8_MMA(1, 0, At, B0); PG8_MMA(1, 1, At, B1); PG8_BAR; PG8_SCHED;
        }
        if (wr == 0) PG8_BAR;
        const bool keep = E(acc, cur, wr, wc, fr, fq);
        if (!has_next) break;
        if (!keep) {
#pragma unroll
            for (int a = 0; a < 2; ++a)
#pragma unroll
                for (int b = 0; b < 2; ++b)
#pragma unroll
                    for (int m = 0; m < 4; ++m)
#pragma unroll
                        for (int n = 0; n < 2; ++n) acc[a][b][m][n] = (f32x4){0.f, 0.f, 0.f, 0.f};
        }
        cur = nxt; cA = nA; cB = nB; ++ui;
        if (wr == 1) PG8_BAR;
    }
    PG8_WAIT_V(0);
    PG8_BAR;
#undef PG8_SA
#undef PG8_SB
#undef PG8_STAGE
#undef PG8_LDA
#undef PG8_LDB
#undef PG8_MMA
#undef PG8_WAIT_V
#undef PG8_WAIT_L
#undef PG8_BAR
#undef PG8_SCHED
}
}

struct Args { const float* in[18]; float* out; unsigned char* ws; int ph_lo, ph_hi; };
enum { I_X = 0, I_WIN, I_CONVW, I_CONVB, I_WRG, I_BRG, I_WIG, I_BIG, I_LAM, I_SINK, I_WBR, I_WOUT, I_LN1G, I_LN1B, I_WF1, I_WF2, I_LN2G, I_LN2B };

template <int MODE>
__device__ __forceinline__ void transpose_item(const float* W, int K, int N, bf16_t* WT, int row_off, LAS float* scr, int item, int lane) {
    const int nblk = N / 32, kb = item / nblk, nb = item % nblk, k0 = 64 * kb, n0 = 32 * nb;
#pragma unroll 8
    for (int i = 0; i < 32; ++i) { const int kk = 2 * i + (lane >> 5); scr[kk * 33 + (lane & 31)] = W[(size_t)(k0 + kk) * N + n0 + (lane & 31)]; }
    LDS_WAIT();
    const int c = lane & 7;
#pragma unroll
    for (int j = 0; j < 4; ++j) { const int n = (lane >> 3) + 8 * j; const LAS float* s = scr + (8 * c) * 33 + n;
        u32x4 o; o.x = pk2(s[0 * 33], s[1 * 33]); o.y = pk2(s[2 * 33], s[3 * 33]); o.z = pk2(s[4 * 33], s[5 * 33]); o.w = pk2(s[6 * 33], s[7 * 33]);
        int row = n0 + n;
        if (MODE == 1) { const int sgl = row >= FFH ? 1 : 0; const int jj = row - sgl * FFH; row = 8 * (jj >> 2) + 4 * sgl + (jj & 3); }
        *(u32x4*)(WT + (size_t)(row_off + row) * K + k0 + 8 * c) = o; }
    LDS_WAIT();
}
__device__ __forceinline__ void phase_weights(const Args& a, int l, unsigned char* ws, LAS unsigned char* lds, int gw, int NGW, int wave, int lane) {
    LAS float* scr = (LAS float*)(lds + wave * 16384);
    constexpr int I_IN = 16 * (INW / 32), I_BR1 = 16 * 32, I_OUT = 16 * 32, I_F1 = 16 * (FF2 / 32), I_F2 = (FFH / 64) * 32;
    constexpr int NIT = I_IN + 3 * I_BR1 + I_OUT + I_F1 + I_F2;
    for (int it = gw; it < NIT; it += NGW) {
        int r = it;
        if (r < I_IN) { transpose_item<0>(a.in[I_WIN] + (size_t)l * DM * INW, DM, INW, (bf16_t*)(ws + WS_WIN), 0, scr, r, lane); continue; } r -= I_IN;
        if (r < 3 * I_BR1) { const int n = r / I_BR1; transpose_item<0>(a.in[I_WBR] + ((size_t)l * 3 + n) * DM * DM, DM, DM, (bf16_t*)(ws + WS_WBR), n * DM, scr, r - n * I_BR1, lane); continue; } r -= 3 * I_BR1;
        if (r < I_OUT) { transpose_item<0>(a.in[I_WOUT] + (size_t)l * DM * DM, DM, DM, (bf16_t*)(ws + WS_WOUT), 0, scr, r, lane); continue; } r -= I_OUT;
        if (r < I_F1) { transpose_item<1>(a.in[I_WF1] + (size_t)l * DM * FF2, DM, FF2, (bf16_t*)(ws + WS_WF1), 0, scr, r, lane); continue; } r -= I_F1;
        transpose_item<0>(a.in[I_WF2] + (size_t)l * FFH * DM, FFH, DM, (bf16_t*)(ws + WS_WF2), 0, scr, r, lane);
    }
}

__device__ __forceinline__ void phase_ln(const float* zx, float* xo, bf16_t* xb, const float* g, const float* b, int nrows, int gw, int NGW, int lane) {
    f32x4 gv[4], bv[4];
#pragma unroll
    for (int j = 0; j < 4; ++j) { gv[j] = *((const f32x4*)g + lane + 64 * j); bv[j] = *((const f32x4*)b + lane + 64 * j); }
    for (int m = gw; m < nrows; m += NGW) {
        const f32x4* xr = (const f32x4*)(zx + (size_t)m * DM) + lane; f32x4* xw = (f32x4*)(xo + (size_t)m * DM) + lane;
        f32x4 v[4]; float s = 0.f;
#pragma unroll
        for (int j = 0; j < 4; ++j) { v[j] = xr[64 * j]; s += (v[j].x + v[j].y) + (v[j].z + v[j].w); }
        const float mean = wave_sum(s) * (1.f / DM); float s2 = 0.f;
#pragma unroll
        for (int j = 0; j < 4; ++j) { v[j] = v[j] - mean; s2 += (v[j].x * v[j].x + v[j].y * v[j].y) + (v[j].z * v[j].z + v[j].w * v[j].w); }
        const float rstd = 1.f / sqrtf(wave_sum(s2) * (1.f / DM) + LN_EPS);
        u32x2* o8 = (u32x2*)(xb + (size_t)m * DM) + lane;
#pragma unroll
        for (int j = 0; j < 4; ++j) { const f32x4 y = v[j] * rstd * gv[j] + bv[j]; xw[64 * j] = y; u32x2 w; w.x = pk2(y.x, y.y); w.y = pk2(y.z, y.w); o8[64 * j] = w; }
    }
}
__device__ __forceinline__ void phase_init(const float* x, bf16_t* xb, int gw, int NGW, int lane) {
    for (int m = gw; m < MTOT; m += NGW) {
        const f32x4* xr = (const f32x4*)(x + (size_t)m * DM) + lane; u32x2* o8 = (u32x2*)(xb + (size_t)m * DM) + lane;
#pragma unroll
        for (int j = 0; j < 4; ++j) { const f32x4 y = xr[64 * j]; u32x2 w; w.x = pk2(y.x, y.y); w.y = pk2(y.z, y.w); o8[64 * j] = w; }
    }
}

constexpr int LRU_A_OFF = 0, LRU_A_PITCH = 144, LRU_XF_OFF = 18432, LRU_XF_PITCH = 33, LRU_AGG_OFF = 18432 + 128 * 33 * 4  , LRU_CARRY_OFF = LRU_AGG_OFF + 8 * 32 * 8;
__device__ __forceinline__ void lru_item(const Args& a, int l, int item, LAS unsigned char* lds, const bf16_t* P, bf16_t* Ya, int tid, int wave, int lane) {
    const int bl = item >> 5, hb = (item >> 1) & 15, half = item & 1;
    const int row0 = bl * SEQ, chb = 64 * hb, cho = chb + 32 * half;
    LAS unsigned char* Abuf = lds + LRU_A_OFF; LAS float* xcf = (LAS float*)(lds + LRU_XF_OFF); LAS float* wagg = (LAS float*)(lds + LRU_AGG_OFF); LAS float* carry = (LAS float*)(lds + LRU_CARRY_OFF);
    const int fr = lane & 15, q = lane >> 4;
    bf16x8 bw[4][2];
#pragma unroll
    for (int nt = 0; nt < 4; ++nt) { const float* wsrc = (nt < 2 ? a.in[I_WRG] : a.in[I_WIG]) + ((size_t)(l * 16 + hb) * 64) * 64 + 32 * half + 16 * (nt & 1) + fr;
#pragma unroll
        for (int ks = 0; ks < 2; ++ks) { unsigned w[4];
#pragma unroll
            for (int j = 0; j < 4; ++j) { const int k = 32 * ks + 8 * q + 2 * j; w[j] = pk2(wsrc[(size_t)k * 64], wsrc[(size_t)(k + 1) * 64]); }
            bw[nt][ks] = __builtin_bit_cast(bf16x8, (u32x4){w[0], w[1], w[2], w[3]}); } }
    float brg[2], big[2], sp[2];
#pragma unroll
    for (int cc = 0; cc < 2; ++cc) { const int ch = cho + 16 * cc + fr; brg[cc] = a.in[I_BRG][l * DM + ch]; big[cc] = a.in[I_BIG][l * DM + ch];
        sp[cc] = 8.0f * log1pf(expf(-a.in[I_LAM][l * DM + ch])); }
    const int cp = tid & 31, tg = tid >> 5; const int cch = chb + 2 * cp;
    float cw[4][2], cb[2];
#pragma unroll
    for (int j = 0; j < 4; ++j) { cw[j][0] = a.in[I_CONVW][(l * 4 + j) * DM + cch]; cw[j][1] = a.in[I_CONVW][(l * 4 + j) * DM + cch + 1]; }
    cb[0] = a.in[I_CONVB][l * DM + cch]; cb[1] = a.in[I_CONVB][l * DM + cch + 1];
    if (tid < 64) carry[tid] = 0.f;
    for (int tile = 0; tile < SEQ / 128; ++tile) {
        const int t0 = tile * 128, par = tile & 1;
        {
            float xv[11][2];
#pragma unroll
            for (int j = 0; j < 11; ++j) { const int t = t0 + 8 * tg - 3 + j; unsigned w = 0u; if (t >= 0) w = *(const unsigned*)(P + (size_t)(row0 + t) * INW + C_LX + cch); xv[j][0] = bf_lo(w); xv[j][1] = bf_hi(w); }
#pragma unroll
            for (int i = 0; i < 8; ++i) { float x0 = cb[0], x1 = cb[1];
#pragma unroll
                for (int j = 0; j < 4; ++j) { x0 += cw[j][0] * xv[i + j][0]; x1 += cw[j][1] * xv[i + j][1]; }
                const int tt = 8 * tg + i;
                *(LAS unsigned*)(Abuf + tt * LRU_A_PITCH + 4 * cp) = pk2(x0, x1);
                if ((cp >> 4) == half) { xcf[tt * LRU_XF_PITCH + 2 * (cp & 15)] = x0; xcf[tt * LRU_XF_PITCH + 2 * (cp & 15) + 1] = x1; } }
        }
        LDS_WAIT(); __syncthreads();
        f32x4 acc[4];
#pragma unroll
        for (int nt = 0; nt < 4; ++nt) acc[nt] = (f32x4){0.f, 0.f, 0.f, 0.f};
#pragma unroll
        for (int ks = 0; ks < 2; ++ks) { const bf16x8 af = *(const LAS bf16x8*)(Abuf + (16 * wave + fr) * LRU_A_PITCH + 64 * ks + 16 * q);
#pragma unroll
            for (int nt = 0; nt < 4; ++nt) acc[nt] = __builtin_amdgcn_mfma_f32_16x16x32_bf16(af, bw[nt][ks], acc[nt], 0, 0, 0); }
        bf16_t gt[2][4];
#pragma unroll
        for (int cc = 0; cc < 2; ++cc)
#pragma unroll
            for (int i = 0; i < 4; ++i) gt[cc][i] = P[(size_t)(row0 + t0 + 16 * wave + 4 * q + i) * INW + C_LG + cho + 16 * cc + fr];
        float A_[2][4], H_[2][4], Ae[2], He[2];
#pragma unroll
        for (int cc = 0; cc < 2; ++cc) {
            float av[4], bv[4];
#pragma unroll
            for (int i = 0; i < 4; ++i) { const int tt = 16 * wave + 4 * q + i;
                const float r = sigm(acc[cc][i] + brg[cc]), ig = sigm(acc[cc + 2][i] + big[cc]);
                const float la = -r * sp[cc];
                av[i] = ex2(la * LOG2E); const float mult = __builtin_amdgcn_sqrtf(1.0f - av[i] * av[i]);
                bv[i] = mult * ig * xcf[tt * LRU_XF_PITCH + 16 * cc + fr]; }
            H_[cc][0] = bv[0]; A_[cc][0] = av[0];
#pragma unroll
            for (int i = 1; i < 4; ++i) { H_[cc][i] = av[i] * H_[cc][i - 1] + bv[i]; A_[cc][i] = av[i] * A_[cc][i - 1]; }
            float Ag = A_[cc][3], Hg = H_[cc][3];
            float t = __shfl_up(Ag, 16), u = __shfl_up(Hg, 16); if (q >= 1) { Hg = Ag * u + Hg; Ag = Ag * t; }
            t = __shfl_up(Ag, 32); u = __shfl_up(Hg, 32); if (q >= 2) { Hg = Ag * u + Hg; Ag = Ag * t; }
            t = __shfl_up(Ag, 16); u = __shfl_up(Hg, 16); Ae[cc] = q ? t : 1.0f; He[cc] = q ? u : 0.0f;
            if (q == 3) { wagg[(wave * 32 + 16 * cc + fr) * 2] = Ag; wagg[(wave * 32 + 16 * cc + fr) * 2 + 1] = Hg; }
        }
        LDS_WAIT(); __syncthreads();
#pragma unroll
        for (int cc = 0; cc < 2; ++cc) { const int c = 16 * cc + fr;
            float hin = carry[par * 32 + c];
            for (int w2 = 0; w2 < wave; ++w2) hin = wagg[(w2 * 32 + c) * 2] * hin + wagg[(w2 * 32 + c) * 2 + 1];
            const float hl = Ae[cc] * hin + He[cc];
#pragma unroll
            for (int i = 0; i < 4; ++i) { const float hv = A_[cc][i] * hl + H_[cc][i];
                if (i == 3 && wave == 7 && q == 3) carry[(par ^ 1) * 32 + c] = hv;
                const float gx = bf2f(gt[cc][i]); const float uu = 0.7978845608028654f * (gx + 0.044715f * gx * gx * gx);
                const float yv = hv * gx * sigm(2.0f * uu);
                Ya[(size_t)(row0 + t0 + 16 * wave + 4 * q + i) * DM + cho + c] = (bf16_t)f2bf(yv); } }
    }
    LDS_WAIT(); __syncthreads();
}

enum { M_BAND = 0, M_NONE = 1, M_BGEN = 2, M_BNEAR = 3, M_BFAR = 4 };
template <int MODE>
__device__ __forceinline__ void attn_tile(f32x16& o0, f32x16& o1, float& m, float& lsum, const int kroff, const bf16x8 (&qf)[4], const int dbase,
                                          const float (&bonus)[4], const float (&farv)[4], LAS unsigned char* vb, const int vroff) {
    constexpr float CS = 0.125f * LOG2E;
    const float NINF = -__builtin_inff();
    f32x16 s;
#pragma unroll
    for (int i = 0; i < 16; ++i) s[i] = 0.f;
#pragma unroll
    for (int ks = 0; ks < 4; ++ks) { const bf16x8 kc = *(const LAS bf16x8*)(vb + 4096 + kroff + 32 * ks); s = __builtin_amdgcn_mfma_f32_32x32x16_bf16(kc, qf[ks], s, 0, 0, 0); }
    float mx = -1e30f;
#pragma unroll
    for (int i = 0; i < 16; ++i) { const int ci = (i & 3) + 8 * (i >> 2);
        if (MODE == M_NONE) s[i] = s[i] * CS;
        else { float lw;
            if (MODE == M_BAND) { const int dlt = dbase - ci; lw = ((unsigned)dlt <= 128u) ? 0.f : NINF; }
            else if (MODE == M_BGEN) { const int dlt = dbase - 4 * ci; lw = ((unsigned)dlt <= 512u) ? bonus[i & 3] : (dlt >= 0 ? farv[i & 3] : NINF); }
            else if (MODE == M_BNEAR) lw = bonus[i & 3];
            else lw = farv[i & 3];
            s[i] = s[i] * CS + lw; }
        mx = fmaxf(mx, s[i]); }
    mx = fmaxf(mx, __shfl_xor(mx, 32));
    const float mn = fmaxf(m, mx); const float alpha = ex2(m - mn);
    float rs = 0.f;
#pragma unroll
    for (int i = 0; i < 16; ++i) { s[i] = ex2(s[i] - mn); rs += s[i]; }
    lsum = lsum * alpha + rs;
    if (__builtin_amdgcn_ballot_w64(mn > m) != 0ull) {
#pragma unroll
        for (int i = 0; i < 16; ++i) { o0[i] *= alpha; o1[i] *= alpha; } }
    m = mn;
    bf16x8 pf[2];
#pragma unroll
    for (int sb = 0; sb < 2; ++sb) { u32x4 w; w.x = pk2(s[8 * sb + 0], s[8 * sb + 1]); w.y = pk2(s[8 * sb + 2], s[8 * sb + 3]); w.z = pk2(s[8 * sb + 4], s[8 * sb + 5]); w.w = pk2(s[8 * sb + 6], s[8 * sb + 7]);
        pf[sb] = __builtin_bit_cast(bf16x8, w); }
    LDS_WAIT();
#pragma unroll
    for (int dt = 0; dt < 2; ++dt)
#pragma unroll
        for (int sb = 0; sb < 2; ++sb) {
            const s16x4 v0 = __builtin_bit_cast(s16x4, __builtin_amdgcn_ds_read_tr16_b64_v4i16((LAS s16x4*)(vb + vroff + dt * 2048 + sb * 1024)));
            const s16x4 v1 = __builtin_bit_cast(s16x4, __builtin_amdgcn_ds_read_tr16_b64_v4i16((LAS s16x4*)(vb + vroff + dt * 2048 + sb * 1024 + 512)));
            const bf16x8 vf = (bf16x8){v0[0], v0[1], v0[2], v0[3], v1[0], v1[1], v1[2], v1[3]};
            if (dt == 0) o0 = __builtin_amdgcn_mfma_f32_32x32x16_bf16(vf, pf[sb], o0, 0, 0, 0);
            else o1 = __builtin_amdgcn_mfma_f32_32x32x16_bf16(vf, pf[sb], o1, 0, 0, 0);
        }
}
__device__ __forceinline__ void attn_item(const bf16_t* __restrict__ P, bf16_t* __restrict__ Y, int row0, int qcol, int kcol, int vcol, int ycol, int tq, int tq0,
                                          int a0, int nA, int r4, int nB, float sink2, bool has_sink, LAS unsigned char* vb, int lane) {
    const int r = lane & 31, h = lane >> 5;
    bf16x8 qf[4];
    { const bf16_t* qp = P + (size_t)(row0 + tq) * INW + qcol + 8 * h;
#pragma unroll
      for (int ks = 0; ks < 4; ++ks) qf[ks] = *(const bf16x8*)(qp + 16 * ks); }
    f32x16 o0, o1;
#pragma unroll
    for (int i = 0; i < 16; ++i) { o0[i] = 0.f; o1[i] = 0.f; }
    float m = -1e30f, lsum = 0.f;
    float bonus[4], farv[4];
#pragma unroll
    for (int k = 0; k < 4; ++k) { bonus[k] = (k == (lane & 3)) ? 1.0f : 0.0f; farv[k] = (k == (lane & 3)) ? 0.0f : -__builtin_inff(); }
    const int nT = nA + nB, blk = nB - 1;
    bf16x8 kf[4], vr[4];
    const int vrow = lane >> 3, vc = lane & 7;
    const unsigned lk1 = (unsigned)((vrow * INW + kcol + 8 * vc) * 2), lk4 = (unsigned)((4 * vrow * INW + kcol + 8 * vc) * 2);
    const unsigned lv1 = (unsigned)((vrow * INW + vcol + 8 * vc) * 2), lv4 = (unsigned)((4 * vrow * INW + vcol + 8 * vc) * 2);
#define ATT_LOAD(ti) do { const bool sb_ = (ti) >= nA; const int kt0_ = sb_ ? r4 + 128 * ((ti) - nA) : a0 + 32 * (ti); \
        const char* pb_ = (const char*)P + (size_t)(unsigned)(row0 + kt0_) * (unsigned)(INW * 2); \
        const unsigned lk_ = sb_ ? lk4 : lk1, lv_ = sb_ ? lv4 : lv1, vs_ = sb_ ? (unsigned)(32 * INW * 2) : (unsigned)(8 * INW * 2); \
        _Pragma("unroll") for (int i = 0; i < 4; ++i) kf[i] = *(const bf16x8*)(pb_ + lk_ + i * vs_); \
        _Pragma("unroll") for (int i = 0; i < 4; ++i) vr[i] = *(const bf16x8*)(pb_ + lv_ + i * vs_); } while (0)
    ATT_LOAD(0);
    const int vwoff = (vc >> 2) * 2048 + vrow * 64 + (vc & 3) * 16, kwoff = vrow * 144 + vc * 16, kroff = r * 144 + 16 * h;
    const int g = lane >> 4, idx = lane & 15;
    const int vroff = (4 * h + (idx >> 2)) * 64 + 32 * (g & 1) + 8 * (idx & 3);
    for (int ti = 0; ti < nT; ++ti) {
        const bool sweepB = ti >= nA;
        const int kt0 = sweepB ? r4 + 128 * (ti - nA) : a0 + 32 * ti;
        asm volatile("" ::: "memory");
#pragma unroll
        for (int i = 0; i < 4; ++i) { *(LAS bf16x8*)(vb + vwoff + i * 512) = vr[i]; *(LAS bf16x8*)(vb + 4096 + kwoff + i * (8 * 144)) = kf[i]; }
        if (ti + 1 < nT) ATT_LOAD(ti + 1);
        LDS_WAIT();
        if (!sweepB) {
            const int du = tq0 - kt0;
            const int dbase = tq - kt0 - 4 * h;
            if (has_sink && (du == 32 || du == 64 || du == 96)) attn_tile<M_NONE>(o0, o1, m, lsum, kroff, qf, dbase, bonus, farv, vb, vroff);
            else attn_tile<M_BAND>(o0, o1, m, lsum, kroff, qf, dbase, bonus, farv, vb, vroff);
        } else {
            const int d = blk - (ti - nA);
            const int dbase = tq - kt0 - 16 * h;
            if (d >= 5) attn_tile<M_BFAR>(o0, o1, m, lsum, kroff, qf, dbase, bonus, farv, vb, vroff);
            else if (d >= 1 && d <= 3) attn_tile<M_BNEAR>(o0, o1, m, lsum, kroff, qf, dbase, bonus, farv, vb, vroff);
            else attn_tile<M_BGEN>(o0, o1, m, lsum, kroff, qf, dbase, bonus, farv, vb, vroff);
        }
        asm volatile("" ::: "memory");
    }
#undef ATT_LOAD
    lsum += __shfl_xor(lsum, 32);
    float scale;
    if (has_sink) { const float mf = fmaxf(m, sink2); const float al = ex2(m - mf); scale = al * rcpf_(lsum * al + ex2(sink2 - mf)); }
    else scale = rcpf_(lsum);
    bf16_t* yp = Y + (size_t)(row0 + tq) * DM + ycol + 4 * h;
#pragma unroll
    for (int g4 = 0; g4 < 4; ++g4) {
        u32x2 w0; w0.x = pk2(o0[4 * g4] * scale, o0[4 * g4 + 1] * scale); w0.y = pk2(o0[4 * g4 + 2] * scale, o0[4 * g4 + 3] * scale); *(u32x2*)(yp + 8 * g4) = w0;
        u32x2 w1; w1.x = pk2(o1[4 * g4] * scale, o1[4 * g4 + 1] * scale); w1.y = pk2(o1[4 * g4 + 2] * scale, o1[4 * g4 + 3] * scale); *(u32x2*)(yp + 32 + 8 * g4) = w1;
    }
}

__device__ __forceinline__ void phase_mixer(const Args& a, int l, LAS unsigned char* lds, const bf16_t* P, bf16_t* Yb, int tid, int wave, int lane, int parts) {
    if (parts & 1) for (int item = blockIdx.x; item < SEQ_PER_CH * 32; item += gridDim.x) lru_item(a, l, item, lds, P, Yb, tid, wave, lane);
    LAS unsigned char* vb = lds + wave * 9216;
    const int W = blockIdx.x * 8 + wave, NW = gridDim.x * 8;
    if (parts & 2) for (int it = W; it < SEQ_PER_CH * 16 * 64; it += NW) {
        const int bl = it >> 10, hq = (it >> 6) & 15, blk = it & 63; const int t0 = 32 * blk;
        const int a0 = t0 >= 128 ? t0 - 128 : 0, nA = (t0 + 32 - a0) >> 5;
        attn_item(P, Yb + (size_t)MC * DM, bl * SEQ, C_QB + 64 * hq, C_KB + 64 * (hq >> 2), C_VB + 64 * (hq >> 2), 64 * hq, t0 + (lane & 31), t0, a0, nA, 0, 0,
                  a.in[I_SINK][l * 16 + hq] * LOG2E, true, vb, lane);
    }
    if (parts & 4) for (int wk = W; wk < SEQ_PER_CH * 16 * 16; wk += NW) {
        const int bl = wk >> 8, hq = (wk >> 4) & 15, pg = wk & 15, r4 = pg & 3, aa = pg >> 2;
#pragma unroll 1
        for (int k = 0; k < 4; ++k) {
            const int blk = (k == 0) ? aa : (k == 1) ? 7 - aa : (k == 2) ? 8 + aa : 15 - aa; const int T0 = 128 * blk;
            const int a0 = T0 >= 128 ? T0 - 128 : 0, nA = (T0 + 128 - a0) >> 5, nB = blk + 1;
            attn_item(P, Yb + (size_t)2 * MC * DM, bl * SEQ, C_QC + 64 * hq, C_KC + 64 * hq, C_VC + 64 * hq, 64 * hq, T0 + r4 + 4 * (lane & 31), T0 + r4, a0, nA, r4, nB, 0.f, false, vb, lane);
        }
    }
}


#define XB_TMO      128
#define XB_XCNT(j)  (256  + 64 * (j))
#define XB_XSUB(j)  (1280 + 64 * (j))
#define XB_XGEN(j)  (2304 + 64 * (j))
#define XB_TOP      3328
#define XB_TOPGEN   3392
#define XCD_BAR_WORDS 3456
#define XB_SPIN_CAP (1u << 18)
__device__ __forceinline__ unsigned xb_ld(unsigned* p)              { return __hip_atomic_load(p, __ATOMIC_RELAXED, __HIP_MEMORY_SCOPE_AGENT); }
__device__ __forceinline__ unsigned xb_add(unsigned* p, unsigned v) { return __hip_atomic_fetch_add(p, v, __ATOMIC_RELAXED, __HIP_MEMORY_SCOPE_AGENT); }
__device__ __forceinline__ unsigned xb_xcc_id() { return (unsigned)__builtin_amdgcn_s_getreg((3 << 11) | 20) & 0xFu; }
#define XB_SPIN(cond, bar) do { unsigned _sp = 0; while (cond) { __builtin_amdgcn_s_sleep(1); \
    if ((++_sp & 255u) == 0u) { if (xb_ld(&(bar)[XB_TMO])) break; if (_sp > XB_SPIN_CAP) { atomicAdd(&(bar)[XB_TMO], 1u); break; } } } } while (0)
struct XcdBarrier { unsigned* bar; unsigned x; volatile LAS unsigned* st; };
__device__ __forceinline__ XcdBarrier xcd_barrier_post(unsigned* bar, volatile LAS unsigned* st) {
    XcdBarrier b; b.bar = bar; b.x = xb_xcc_id(); b.st = st;
    if (threadIdx.x == 0) (void)xb_add(&bar[XB_XCNT(b.x)], 1u);
    return b;
}
__device__ __forceinline__ void xcd_barrier_complete(unsigned* bar, unsigned x, unsigned& nloc, unsigned& nx) {
    const unsigned G = gridDim.x * gridDim.y * gridDim.z;
    unsigned sum, cnt, mine, sp = 0u;
    for (;;) {
        sum = 0u; cnt = 0u; mine = 0u;
#pragma unroll
        for (unsigned j = 0; j < 16; ++j) { const unsigned c = xb_ld(&bar[XB_XCNT(j)]); sum += c; cnt += (c > 0u) ? 1u : 0u; mine = (j == x) ? c : mine; }
        if (sum == G) break;
        __builtin_amdgcn_s_sleep(1);
        if ((++sp & 255u) == 0u) { if (xb_ld(&bar[XB_TMO])) break; if (sp > XB_SPIN_CAP) { atomicAdd(&bar[XB_TMO], 1u); break; } }
    }
    nloc = mine > 0u ? mine : 1u; nx = cnt > 0u ? cnt : 1u;
}
__device__ __forceinline__ void xcd_barrier(const XcdBarrier& b) {
    asm volatile("s_waitcnt vmcnt(0)" ::: "memory");
    __syncthreads();
    if (threadIdx.x == 0) {
        unsigned* bar = b.bar;
        __builtin_amdgcn_s_waitcnt(0);
        unsigned nloc = b.st[0], nx = b.st[1];
        if (nloc == 0u) { xcd_barrier_complete(bar, b.x, nloc, nx); b.st[0] = nloc; b.st[1] = nx; }
        const unsigned old = xb_add(&bar[XB_XSUB(b.x)], 1u);
        const unsigned gen = old / nloc;
        if (old + 1u == (gen + 1u) * nloc) {
            __builtin_amdgcn_fence(__ATOMIC_RELEASE, "agent");
            asm volatile("s_waitcnt vmcnt(0)" ::: "memory");
            const unsigned og = xb_add(&bar[XB_TOP], 1u);
            const unsigned tg = og / nx;
            if (og + 1u == (tg + 1u) * nx) xb_add(&bar[XB_TOPGEN], 1u);
            else XB_SPIN(xb_ld(&bar[XB_TOPGEN]) == tg, bar);
            __builtin_amdgcn_fence(__ATOMIC_ACQUIRE, "agent");
            xb_add(&bar[XB_XGEN(b.x)], 1u);
            asm volatile("s_waitcnt vmcnt(0)" ::: "memory");
        } else {
            XB_SPIN(xb_ld(&bar[XB_XGEN(b.x)]) == gen, bar);
            __builtin_amdgcn_fence(__ATOMIC_ACQUIRE, "agent");
            asm volatile("s_waitcnt vmcnt(0)" ::: "memory");
        }
    }
    __syncthreads();
}

__global__ void __launch_bounds__(512, 2) mega_fwd(Args a) {
    extern __shared__ __attribute__((aligned(16))) unsigned char lds_raw[];
    LAS unsigned char* lds = (LAS unsigned char*)lds_raw;
    const int tid = threadIdx.x, lane = tid & 63, wave = __builtin_amdgcn_readfirstlane(tid >> 6);
    const int G = gridDim.x, gw = blockIdx.x * 8 + wave, NGW = G * 8;
    unsigned char* ws = a.ws;
    bf16_t* XB = (bf16_t*)(ws + WS_XB); bf16_t* PROJ = (bf16_t*)(ws + WS_PROJ); bf16_t* YB = (bf16_t*)(ws + WS_Y); bf16_t* MRG = (bf16_t*)(ws + WS_MRG); bf16_t* HB = (bf16_t*)(ws + WS_H);
    cg::grid_group grid = cg::this_grid();
    volatile LAS unsigned* MISC = (volatile LAS unsigned*)(lds + 131072);
    if (tid < 64) MISC[tid] = 0u;
    __syncthreads();
    unsigned* barw = (unsigned*)(ws + WS_CTL);
    XcdBarrier bar; bar.bar = barw; bar.x = 0; bar.st = MISC + 8;
    const bool multi_phase = (a.ph_hi - a.ph_lo) > 1;
    if (multi_phase) {
        for (int i = blockIdx.x * 512 + tid; i < XCD_BAR_WORDS; i += G * 512) barw[i] = 0u;
        grid.sync();
        bar = xcd_barrier_post(barw, MISC + 8);
    }
    const int tid0 = tid, lane0 = lane;
#pragma unroll 1
    for (int ph = a.ph_lo; ph < a.ph_hi; ++ph) {
        if (ph > a.ph_lo) { if (PROBE_ST == 11) grid.sync(); else xcd_barrier(bar); if (PROBE_ST == 9) { for (int r9 = 0; r9 < PROBE_REP; ++r9) xcd_barrier(bar); } }
        int tid = tid0, lane = lane0; asm volatile("" : "+v"(tid), "+v"(lane));
        if (ph == 0) { phase_init(a.in[I_X], XB, gw, NGW, lane); continue; }
        const int qq = ph - 1, l = qq / 17, rr = qq % 17;
        if (rr == 0) { for (int r8 = 0; r8 <= (PROBE_ST == 8 ? PROBE_REP : 0); ++r8) phase_weights(a, l, ws, lds, gw, NGW, wave, lane); if (PROBE_ST == 10) phase_weights(a, (l + 2) & 3, ws + WS_END, lds, gw, NGW, wave, lane); continue; }
        const int c = (rr - 1) >> 3, st = (rr - 1) & 7;
        const size_t crow = (size_t)c * MC;
        float* xres = a.out + crow * DM; bf16_t* xb = XB + crow * DM;
        const int nrep = (st == PROBE_ST || st + 20 == PROBE_ST) ? PROBE_REP : 0;
#pragma unroll 1
        for (int rep = 0; rep <= nrep; ++rep) {
        float* xdst = (rep < nrep) ? (float*)(ws + WS_END) : xres;
        if (rep) { if (PROBE_ST >= 20) xcd_barrier(bar); else __syncthreads(); }
        int tid = tid0, lane = lane0; asm volatile("" : "+v"(tid), "+v"(lane));
        if (st == 0 && (PH_MASK & 1)) {
            pg8::StaticOrder S; S.init(MC, INW, G, (int)blockIdx.x); pg8::EpiProj E{PROJ, INW};
            pg8::gemm_phase(lds, xb, DM, (const bf16_t*)(ws + WS_WIN), DM, S, E, tid);
        } else if (st == 1 && (PH_MASK & 2)) {
            phase_mixer(a, l, lds, PROJ, YB, tid, wave, lane, 7);
            if (PROBE_ST >= 30 && PROBE_ST <= 32) { __syncthreads(); phase_mixer(a, l, lds, PROJ, YB, tid, wave, lane, 1 << (PROBE_ST - 30)); }
        } else if (st == 2 && (PH_MASK & 4)) {
            pg8::BranchOrder S; S.init(G, (int)blockIdx.x); pg8::EpiBranch E{PROJ, MRG};
            pg8::gemm_phase(lds, YB, DM, (const bf16_t*)(ws + WS_WBR), DM, S, E, tid);
        } else if (st == 3 && (PH_MASK & 8)) {
            pg8::StaticOrder S; S.init(MC, DM, G, (int)blockIdx.x); pg8::EpiResid E{(l == 0 ? a.in[I_X] : a.out) + crow * DM, xdst};
            pg8::gemm_phase(lds, MRG, DM, (const bf16_t*)(ws + WS_WOUT), DM, S, E, tid);
        } else if (st == 4 && (PH_MASK & 16)) {
            phase_ln(xres, xdst, xb, a.in[I_LN1G] + l * DM, a.in[I_LN1B] + l * DM, MC, gw, NGW, lane);
        } else if (st == 5 && (PH_MASK & 32)) {
            pg8::StaticOrder S; S.init(MC, FF2, G, (int)blockIdx.x); pg8::EpiSwiGLU E{HB};
            pg8::gemm_phase(lds, xb, DM, (const bf16_t*)(ws + WS_WF1), DM, S, E, tid);
        } else if (st == 6 && (PH_MASK & 64)) {
            pg8::StaticOrder S; S.init(MC, DM, G, (int)blockIdx.x); pg8::EpiResid E{xres, xdst};
            pg8::gemm_phase(lds, HB, FFH, (const bf16_t*)(ws + WS_WF2), FFH, S, E, tid);
        } else if (PH_MASK & 128) {
            phase_ln(xres, xdst, xb, a.in[I_LN2G] + l * DM, a.in[I_LN2B] + l * DM, MC, gw, NGW, lane);
        }
        }
    }
}

extern "C" void kernel_launch(void* const* d_in, const int* in_sizes, int n_in, void* d_out, int out_size, void* d_ws, size_t ws_size, hipStream_t stream) {
    static int grid = 0;
    if (grid == 0) {
        if (n_in != 18 || out_size != MTOT * DM || ws_size < WS_NEED) { fprintf(stderr, "kernel_launch: unexpected shapes (n_in %d out %d ws %zu)\n", n_in, out_size, ws_size); grid = -1; return; }
        int dev = 0, cus = 0, per_cu = 0;
        hipGetDevice(&dev); hipDeviceGetAttribute(&cus, hipDeviceAttributeMultiprocessorCount, dev);
        if (hipFuncSetAttribute((const void*)mega_fwd, hipFuncAttributeMaxDynamicSharedMemorySize, LDS_BYTES) != hipSuccess) { fprintf(stderr, "kernel_launch: hipFuncSetAttribute failed\n"); grid = -1; return; }
        if (hipOccupancyMaxActiveBlocksPerMultiprocessor(&per_cu, (const void*)mega_fwd, 512, LDS_BYTES) != hipSuccess || per_cu < 1) { fprintf(stderr, "kernel_launch: occupancy query says %d\n", per_cu); per_cu = 1; }
        (void)hipGetLastError();
        grid = cus * per_cu;
    }
    if (grid < 0) return;
    Args a{};
    for (int i = 0; i < 18; ++i) a.in[i] = (const float*)d_in[i];
    a.out = (float*)d_out; a.ws = (unsigned char*)d_ws;
#if MK_MULTI
    for (int ph = 0; ph < NPH; ++ph) { a.ph_lo = ph; a.ph_hi = ph + 1; hipLaunchKernelGGL(mega_fwd, dim3(grid), dim3(512), LDS_BYTES, stream, a); }
#else
    a.ph_lo = 0; a.ph_hi = NPH;
    void* args[] = {&a};
    hipError_t e = hipLaunchCooperativeKernel((const void*)mega_fwd, dim3(grid), dim3(512), args, LDS_BYTES, stream);
    if (e != hipSuccess) fprintf(stderr, "cooperative launch failed: %s (grid %d)\n", hipGetErrorString(e), grid);
#endif
}
```
